# Optimizing an MI355X kernel written in HIP

```python
import math
import jax, jax.numpy as jnp
from jax import lax
import numpy as np

D_MODEL = 1024
BATCH = 2
SEQ = 16384
DEPTH = 2

LRU_W = 256
LRU_BLOCKS = 4
LRU_BLOCK_W = LRU_W // LRU_BLOCKS
LRU_C = 8.0
CONV_W = 4
MLSTM_HEADS = 4
MLSTM_HEAD_DIM = 64
MLSTM_W = MLSTM_HEADS * MLSTM_HEAD_DIM
MLSTM_CHUNK = 64
SB_HEADS = 4
SB_HEAD_DIM = 64
SB_W = SB_HEADS * SB_HEAD_DIM
SB_BLOCK = 128
FF = ((8 * D_MODEL // 3 + 255) // 256) * 256
EPS = 1e-6

SPLIT_SIZES = (LRU_W, LRU_W, 2 * MLSTM_W, MLSTM_W, MLSTM_W, MLSTM_HEADS, MLSTM_HEADS,
               SB_W, SB_W, SB_W, D_MODEL, D_MODEL, D_MODEL)
IN_COLS = sum(SPLIT_SIZES)

kernel_name = "hybrid_rglru_mlstm_stickbreaking_block"


def rmsnorm(x, g):
    xf = x.astype(jnp.float32)
    y = xf * lax.rsqrt(jnp.mean(xf * xf, axis=-1, keepdims=True) + EPS)
    return (y * g.astype(jnp.float32)).astype(x.dtype)


def causal_dwconv(x, w):
    K, C = w.shape
    return lax.conv_general_dilated(
        x, w.astype(x.dtype)[:, None, :], window_strides=(1,), padding=[(K - 1, 0)],
        dimension_numbers=("NWC", "WIO", "NWC"), feature_group_count=C)


def to_heads(t, n_heads):
    B, S, W = t.shape
    return t.reshape(B, S, n_heads, W // n_heads).transpose(0, 2, 1, 3)


def from_heads(t):
    B, H, S, d = t.shape
    return t.transpose(0, 2, 1, 3).reshape(B, S, H * d)


def rg_lru(xb, wa, ba, wx, bx, lam):
    B, S, W = xb.shape
    xf = xb.astype(jnp.float32)
    xh = xf.reshape(B, S, LRU_BLOCKS, LRU_BLOCK_W)
    r = jax.nn.sigmoid(jnp.einsum('bsgi,gij->bsgj', xh, wa.astype(jnp.float32)).reshape(B, S, W)
                       + ba.astype(jnp.float32))
    i = jax.nn.sigmoid(jnp.einsum('bsgi,gij->bsgj', xh, wx.astype(jnp.float32)).reshape(B, S, W)
                       + bx.astype(jnp.float32))
    log_a = -LRU_C * r * jax.nn.softplus(-lam.astype(jnp.float32))
    a = jnp.exp(log_a)
    u = jnp.sqrt(-jnp.expm1(2.0 * log_a)) * (i * xf)

    def combine(left, right):
        a1, b1 = left
        a2, b2 = right
        return a1 * a2, a2 * b1 + b2

    _, h = lax.associative_scan(combine, (a, u), axis=1)
    return h.astype(xb.dtype)


def mlstm_chunkwise(q, k, v, i_pre, f_pre):
    B, H, S, dk = q.shape
    dv = v.shape[-1]
    L = MLSTM_CHUNK
    nc = S // L
    out_dtype = v.dtype
    q = q.astype(jnp.float32)
    k = k.astype(jnp.float32) * (dk ** -0.5)
    v = v.astype(jnp.float32)
    logi = i_pre.astype(jnp.float32)
    logf = jax.nn.log_sigmoid(f_pre.astype(jnp.float32))

    def chunks(t):
        return jnp.moveaxis(t.reshape((B, H, nc, L) + t.shape[3:]), 2, 0)

    tril = jnp.tril(jnp.ones((L, L), dtype=bool))

    def step(carry, inp):
        C, n, m = carry
        qc, kc, vc, ic, fc = inp
        b = jnp.cumsum(fc, axis=-1)
        D = jnp.where(tril, b[..., :, None] - b[..., None, :] + ic[..., None, :], -jnp.inf)
        m_inter = b + m[..., None]
        m_t = jnp.maximum(jnp.max(D, axis=-1), m_inter)
        P = jnp.exp(D - m_t[..., None]) * jnp.einsum('bhtk,bhsk->bhts', qc, kc)
        decay = jnp.exp(m_inter - m_t)
        num = (jnp.einsum('bhts,bhsv->bhtv', P, vc)
               + decay[..., None] * jnp.einsum('bhvk,bhtk->bhtv', C, qc))
        den = jnp.sum(P, axis=-1) + decay * jnp.einsum('bhk,bhtk->bht', n, qc)
        h = num / jnp.maximum(jnp.abs(den), jnp.exp(-m_t))[..., None]
        bL = b[..., -1]
        g = bL[..., None] - b + ic
        m_new = jnp.maximum(bL + m, jnp.max(g, axis=-1))
        wts = jnp.exp(g - m_new[..., None])
        carry_decay = jnp.exp(bL + m - m_new)
        C = carry_decay[..., None, None] * C + jnp.einsum('bhs,bhsv,bhsk->bhvk', wts, vc, kc)
        n = carry_decay[..., None] * n + jnp.einsum('bhs,bhsk->bhk', wts, kc)
        return (C, n, m_new), h

    init = (jnp.zeros((B, H, dv, dk), jnp.float32), jnp.zeros((B, H, dk), jnp.float32),
            jnp.zeros((B, H), jnp.float32))
    _, hs = lax.scan(step, init, (chunks(q), chunks(k), chunks(v), chunks(logi), chunks(logf)))
    return jnp.moveaxis(hs, 0, 2).reshape(B, H, S, dv).astype(out_dtype)


def stick_breaking_attention(q, k, v):
    B, H, S, d = q.shape
    nb = S // SB_BLOCK
    scale = 1.0 / math.sqrt(d)
    loc = jnp.arange(SB_BLOCK)
    diag_mask = loc[None, :] < loc[:, None]
    outs = []
    for bi in range(nb):
        nk = bi + 1
        lk_len = nk * SB_BLOCK
        qblk = q[:, :, bi * SB_BLOCK:(bi + 1) * SB_BLOCK]
        kk = k[:, :, :lk_len]
        vv = v[:, :, :lk_len]
        z = jnp.einsum('bhqd,bhsd->bhqs', qblk, kk).astype(jnp.float32) * scale
        causal = jnp.concatenate(
            [jnp.ones((SB_BLOCK, lk_len - SB_BLOCK), dtype=bool), diag_mask], axis=1)
        log_keep = jnp.where(causal, jax.nn.log_sigmoid(-z), 0.0)
        intra = lax.cumsum(log_keep.reshape(B, H, SB_BLOCK, nk, SB_BLOCK), axis=4, reverse=True)
        bsum = intra[..., 0]
        inter = lax.cumsum(bsum, axis=3, reverse=True) - bsum
        R = (intra + inter[..., None]).reshape(B, H, SB_BLOCK, lk_len)
        A = jnp.where(causal, jnp.exp(z + R), 0.0)
        outs.append(jnp.einsum('bhqs,bhsd->bhqd', A.astype(v.dtype), vv))
    return jnp.concatenate(outs, axis=2)


def setup_inputs(seed: int = 0) -> dict:
    key = jax.random.key(seed)
    ks = jax.random.split(key, 24)
    f32 = jnp.float32
    D = D_MODEL

    def nrm(k, shape, fan_in):
        return jax.random.normal(k, shape, f32) * (fan_in ** -0.5)

    a0 = jax.random.uniform(ks[8], (DEPTH, LRU_W), f32, 0.9, 0.999)
    s0 = a0 ** (1.0 / LRU_C)
    lru_lambda = jnp.log(s0) - jnp.log1p(-s0)
    fg_b = (jnp.linspace(3.0, 6.0, MLSTM_HEADS, dtype=f32)[None, :]
            + 0.1 * jax.random.normal(ks[11], (DEPTH, MLSTM_HEADS), f32))
    return {
        "x": jax.random.normal(ks[0], (BATCH, SEQ, D), f32),
        "norm_mix_g": 1.0 + 0.02 * jax.random.normal(ks[1], (DEPTH, D), f32),
        "w_in": nrm(ks[2], (DEPTH, D, IN_COLS), D),
        "conv_lru_w": nrm(ks[3], (DEPTH, CONV_W, LRU_W), CONV_W),
        "lru_wa": nrm(ks[4], (DEPTH, LRU_BLOCKS, LRU_BLOCK_W, LRU_BLOCK_W), LRU_BLOCK_W),
        "lru_ba": 0.02 * jax.random.normal(ks[5], (DEPTH, LRU_W), f32),
        "lru_wx": nrm(ks[6], (DEPTH, LRU_BLOCKS, LRU_BLOCK_W, LRU_BLOCK_W), LRU_BLOCK_W),
        "lru_bx": 0.02 * jax.random.normal(ks[7], (DEPTH, LRU_W), f32),
        "lru_lambda": lru_lambda,
        "conv_mlstm_w": nrm(ks[9], (DEPTH, CONV_W, 2 * MLSTM_W), CONV_W),
        "mlstm_ig_b": 0.1 * jax.random.normal(ks[10], (DEPTH, MLSTM_HEADS), f32),
        "mlstm_fg_b": fg_b,
        "w_out_lru": nrm(ks[12], (DEPTH, LRU_W, D), LRU_W),
        "w_out_mlstm": nrm(ks[13], (DEPTH, MLSTM_W, D), MLSTM_W),
        "w_out_sb": nrm(ks[14], (DEPTH, SB_W, D), SB_W),
        "w_o": nrm(ks[15], (DEPTH, D, D), D),
        "norm_ffn_g": 1.0 + 0.02 * jax.random.normal(ks[16], (DEPTH, D), f32),
        "w_ffn_in": nrm(ks[17], (DEPTH, D, 2 * FF), D),
        "w_ffn_out": nrm(ks[18], (DEPTH, FF, D), FF),
        "final_norm_g": 1.0 + 0.02 * jax.random.normal(ks[19], (D,), f32),
    }


def reference(x, norm_mix_g, w_in, conv_lru_w, lru_wa, lru_ba, lru_wx, lru_bx, lru_lambda,
              conv_mlstm_w, mlstm_ig_b, mlstm_fg_b, w_out_lru, w_out_mlstm, w_out_sb, w_o,
              norm_ffn_g, w_ffn_in, w_ffn_out, final_norm_g):
    split_points = np.cumsum(SPLIT_SIZES)[:-1].tolist()
    for l in range(DEPTH):
        h = rmsnorm(x, norm_mix_g[l])
        proj = h @ w_in[l]
        (lru_x, lru_gate, m_qk, m_v, m_o, m_i, m_f,
         s_q, s_k, s_v, g_a, g_b, g_c) = jnp.split(proj, split_points, axis=-1)

        xa = causal_dwconv(lru_x, conv_lru_w[l])
        ya = rg_lru(xa, lru_wa[l], lru_ba[l], lru_wx[l], lru_bx[l], lru_lambda[l])
        ya = (ya * jax.nn.gelu(lru_gate)) @ w_out_lru[l]

        qk = jax.nn.silu(causal_dwconv(m_qk, conv_mlstm_w[l]))
        mq, mk = jnp.split(qk, 2, axis=-1)
        i_pre = (m_i + mlstm_ig_b[l]).transpose(0, 2, 1)
        f_pre = (m_f + mlstm_fg_b[l]).transpose(0, 2, 1)
        hb = mlstm_chunkwise(to_heads(mq, MLSTM_HEADS), to_heads(mk, MLSTM_HEADS),
                             to_heads(m_v, MLSTM_HEADS), i_pre, f_pre)
        yb = (jax.nn.sigmoid(m_o) * from_heads(hb)) @ w_out_mlstm[l]

        hc = stick_breaking_attention(to_heads(s_q, SB_HEADS), to_heads(s_k, SB_HEADS),
                                      to_heads(s_v, SB_HEADS))
        yc = from_heads(hc) @ w_out_sb[l]

        merged = (jax.nn.sigmoid(g_a) * ya + jax.nn.sigmoid(g_b) * yb
                  + jax.nn.sigmoid(g_c) * yc)
        x = x + merged @ w_o[l]

        hf = rmsnorm(x, norm_ffn_g[l])
        gate, up = jnp.split(hf @ w_ffn_in[l], 2, axis=-1)
        x = x + (jax.nn.silu(gate) * up) @ w_ffn_out[l]
    return rmsnorm(x, final_norm_g)
```

```cpp
#include <hip/hip_runtime.h>
#include <cstdio>
#include <cstdint>

#define DI __device__ __forceinline__
#define GAS __attribute__((address_space(1)))
#define LAS __attribute__((address_space(3)))
typedef unsigned short bf16;
typedef unsigned v4u __attribute__((ext_vector_type(4)));
typedef unsigned v2u __attribute__((ext_vector_type(2)));
typedef float f32x2 __attribute__((ext_vector_type(2)));
typedef float f32x4 __attribute__((ext_vector_type(4)));
typedef float f32x16 __attribute__((ext_vector_type(16)));
typedef short bf16x8 __attribute__((ext_vector_type(8)));
typedef short s16x4 __attribute__((ext_vector_type(4)));
typedef __bf16 bf16x2_t __attribute__((ext_vector_type(2)));

constexpr int BATCH = 2, SEQ = 16384, D = 1024, M = BATCH * SEQ, DEPTH = 2;
constexpr int FF = 2816;
constexpr int NP = 2304;
constexpr int C_LX = 0, C_LG = 256, C_MQ = 512, C_MK = 768, C_MV = 1024, C_MO = 1280, C_SQ = 1536, C_SK = 1792, C_SV = 2048, C_GA = 2304;
constexpr int IN_COLS = 5384;
constexpr float EPS = 1e-6f;
constexpr int LCH = 128, NLCH = SEQ / LCH;
constexpr int MCH = 64, NMCH = SEQ / MCH;

constexpr size_t MiB = 1u << 20;
constexpr size_t WS_CTL = 0, CTL_ZERO_BYTES = 64 * 1024;
constexpr size_t WS_SSQ = 503 * MiB;
constexpr size_t WS_WL0 = 2 * MiB, WS_WLSTRIDE = 33 * MiB;
constexpr size_t WO_WIN = 0;
constexpr size_t WO_WOUT = 11 * MiB;
constexpr size_t WO_WO = 13 * MiB;
constexpr size_t WO_WF1 = 15 * MiB;
constexpr size_t WO_WF2 = 26 * MiB;
constexpr size_t WO_LRUW = 32 * MiB;
constexpr size_t WS_LSUM = 68 * MiB;
constexpr size_t WS_MSC = 68 * MiB + 512 * 1024;
constexpr size_t WS_IF = 69 * MiB;
constexpr size_t WS_MST = 70 * MiB;
constexpr size_t WS_MSN = 102 * MiB;
constexpr size_t WS_XN = 103 * MiB;
constexpr size_t WS_PROJ = 167 * MiB;
constexpr size_t WS_GATES = WS_PROJ + 144 * MiB;
constexpr size_t WO_W8F = WO_WF1, WO_CSF = WO_WF1 + 6 * MiB;
constexpr float QCLIP = 127.f / 4.5f;
constexpr size_t WS_A8 = WS_PROJ + 248 * MiB;
constexpr size_t WS_W8 = WS_PROJ + 284 * MiB;
constexpr size_t WS_QSINV = WS_PROJ + 296 * MiB;
constexpr size_t WS_END = 507 * MiB;

constexpr int RING_BYTES = 131072;
constexpr int LDS_BYTES = 147456;
constexpr int LDSCTL_OFF = LDS_BYTES - 512, MISC_OFF = LDSCTL_OFF + 320;
constexpr int CFTAB_OFF = 131072;
constexpr int RSTAB_OFF = 135680;
static_assert(RSTAB_OFF >= RING_BYTES && RSTAB_OFF + 11 * 1024 <= LDSCTL_OFF, "LDS map");

DI unsigned cvtpk(float lo, float hi) { f32x2 v = {lo, hi}; bf16x2_t b = __builtin_convertvector(v, bf16x2_t); return __builtin_bit_cast(unsigned, b); }
DI float bf2f(unsigned short b) { return __uint_as_float(((unsigned)b) << 16); }
DI float bflo(unsigned w) { return __uint_as_float(w << 16); }
DI float bfhi(unsigned w) { return __uint_as_float(w & 0xffff0000u); }
DI float fexp(float x) { return __expf(x); }
DI float frcp(float x) { return __builtin_amdgcn_rcpf(x); }
DI float sigm(float x) { return frcp(1.f + fexp(-x)); }
DI float softplus(float z) { return fmaxf(z, 0.f) + __logf(1.f + fexp(-fabsf(z))); }
DI float siluf(float x) { return x * sigm(x); }
DI float gelu_tanh(float x) { const float u = 0.7978845608028654f * (x + 0.044715f * x * x * x); const float t = 1.f - 2.f * frcp(fexp(2.f * u) + 1.f); return 0.5f * x * (1.f + t); }
#define MFMA32(a, b, c) __builtin_amdgcn_mfma_f32_32x32x16_bf16((a), (b), (c), 0, 0, 0)
DI int crow(int reg, int h) { return (reg & 3) + 8 * (reg >> 2) + 4 * h; }
DI int tau(int m) { return (((m >> 2) & 1) << 4) | ((m >> 3) << 2) | (m & 3); }

namespace pg8 {
#define PG8_LAS __attribute__((address_space(3)))
typedef unsigned short bf16_t;
typedef unsigned u32x4 __attribute__((ext_vector_type(4)));
typedef int i32x4 __attribute__((ext_vector_type(4)));
typedef unsigned u32x2 __attribute__((ext_vector_type(2)));
constexpr int BM = 256, BK = 64, HALF = 128, HTB = HALF * BK * 2, STAGE_BYTES = 8 * HTB, NXCD = 8, WGM = 8;
__host__ __device__ __forceinline__ int lds_byte(int r, int c) { const int st = (r >> 4) * 2 + (c >> 5), rr = r & 15, cc = c & 31, ob = rr * 64 + cc * 2; return st * 1024 + (ob ^ (((ob >> 9) & 1) << 5)); }
__host__ __device__ __forceinline__ void stage_rc(int b, int& R, int& C) { const int st = b / 1024, sb = b % 1024, swz = sb ^ (((sb >> 9) & 1) << 5); R = (st >> 1) * 16 + swz / 64; C = (st & 1) * 32 + (swz % 64) / 2; }
__host__ __device__ __forceinline__ int perm32(int rho) { const int n = rho >> 4, i = rho & 15; return 8 * (i >> 2) + 4 * n + (i & 3); }

struct Unit { int pm, pn; };
struct Gemm { const bf16_t* A; const bf16_t* Bt; int M, N, K, lda, ldb; };
struct StaticOrder {
    int nM, nN, nwg, G, c;
    __host__ __device__ void init(int M_, int N_, int G_, int c_) { nM = M_ / BM; nN = N_ / BM; nwg = nM * nN; G = G_; c = c_; }
    __host__ __device__ bool next(int i, Unit& u) const {
        const long L = (long)i * G + c; if (L >= nwg) return false;
        int wgid = (int)L; { const int q = nwg / NXCD, r = nwg % NXCD, xcd = wgid % NXCD, off = wgid / NXCD; wgid = (xcd < r ? xcd * (q + 1) : r * (q + 1) + (xcd - r) * q) + off; }
        const int nig = WGM * nN, gid = wgid / nig, fm = gid * WGM, gsz = (nM - fm) < WGM ? (nM - fm) : WGM;
        u.pm = fm + ((wgid % nig) % gsz); u.pn = (wgid % nig) / gsz; return true;
    }
};
__device__ __forceinline__ float rstd_of(const float* slots) {
    const f32x4 a = *(const f32x4*)slots, b = *(const f32x4*)(slots + 4), c = *(const f32x4*)(slots + 8), d = *(const f32x4*)(slots + 12);
    const float s = ((a.x + a.y) + (a.z + a.w)) + ((b.x + b.y) + (b.z + b.w)) + (((c.x + c.y) + (c.z + c.w)) + ((d.x + d.y) + (d.z + d.w)));
    return 1.f / sqrtf(s * (1.f / D) + EPS); }
struct AMapLinear { __device__ __forceinline__ size_t operator()(int t) const { return (size_t)t * (BK * 2); } };
struct AMap3 { __device__ __forceinline__ size_t operator()(int t) const { const int s = t >> 2; return (size_t)((256 + 1024 * s - 768 * (s >> 1)) * 2 + (t & 3) * (BK * 2)); } };

template <class Epi, class Sched, class AMap, bool ALIGN_EPI = false, bool SP2 = false, bool I8 = false>
__device__ __forceinline__ void gemm_phase(PG8_LAS unsigned char* lds, const Gemm g, const Sched& S, const Epi& E, const AMap& AM) {
    int tid_ = threadIdx.x; asm volatile("" : "+v"(tid_));
    const int tid = tid_, wid = __builtin_amdgcn_readfirstlane(tid >> 6), lane = tid & 63, wr = wid >> 2, wc = wid & 3, fr = lane & 15, fq = lane >> 4;
    const int K = g.K, nt = K / BK;
    unsigned voffA[2], voffB[2];
#pragma unroll
    for (int i = 0; i < 2; ++i) { int R, C; stage_rc(tid * 16 + i * 8192, R, C); const int Rb = Epi::PERM ? ((R & ~31) + perm32(R & 31)) : R;
        voffA[i] = (unsigned)(R * g.lda + C) * 2u; voffB[i] = (unsigned)(Rb * g.ldb + C) * 2u; }
    const size_t kstep = (size_t)(BK * 2);
    const size_t hstepA = (size_t)HALF * g.lda * 2, hstepB = (size_t)HALF * g.ldb * 2;
    const size_t tstepA = 2 * hstepA, tstepB = 2 * hstepB;
    const unsigned ldsw = (unsigned)wid * 1024u;
    const int aoff = lds_byte(wr * 64 + fr, fq * 8), boff = lds_byte(wc * 32 + fr, fq * 8);
#define PG8_SA(b, h) (((b) * 2 + (h)) * HTB)
#define PG8_SB(b, h) ((4 + (b) * 2 + (h)) * HTB)
#define PG8_STAGE(bufoff, gbase, voff) do { _Pragma("unroll") for (int _i = 0; _i < 2; ++_i) \
        __builtin_amdgcn_global_load_lds((const unsigned*)((const char*)(gbase) + (voff)[_i]), (PG8_LAS unsigned*)(lds + (bufoff) + ldsw + _i * 8192), 16, 0, 0); } while (0)
#define PG8_LDA(dst, b, h) do { _Pragma("unroll") for (int m = 0; m < 4; ++m) _Pragma("unroll") for (int k = 0; k < 2; ++k) dst[m][k] = *(const PG8_LAS bf16x8*)(lds + PG8_SA(b, h) + aoff + m * 2048 + k * 1024); } while (0)
#define PG8_LDB(dst, b, h) do { _Pragma("unroll") for (int n = 0; n < 2; ++n) _Pragma("unroll") for (int k = 0; k < 2; ++k) dst[n][k] = *(const PG8_LAS bf16x8*)(lds + PG8_SB(b, h) + boff + n * 2048 + k * 1024); } while (0)
#define PG8_MMA(ai, bj, At, Bt) do { __builtin_amdgcn_s_setprio(1); _Pragma("unroll") for (int m = 0; m < 4; ++m) _Pragma("unroll") for (int n = 0; n < 2; ++n) _Pragma("unroll") for (int k = 0; k < 2; ++k) { \
        if constexpr (I8) acc[ai][bj][m][n] = __builtin_bit_cast(f32x4, __builtin_amdgcn_mfma_i32_16x16x64_i8(__builtin_bit_cast(i32x4, Bt[n][k]), __builtin_bit_cast(i32x4, At[m][k]), __builtin_bit_cast(i32x4, acc[ai][bj][m][n]), 0, 0, 0)); \
        else acc[ai][bj][m][n] = __builtin_amdgcn_mfma_f32_16x16x32_bf16(Bt[n][k], At[m][k], acc[ai][bj][m][n], 0, 0, 0); } __builtin_amdgcn_s_setprio(0); } while (0)
#define PG8_WAIT_V(n) asm volatile("s_waitcnt vmcnt(" #n ")" ::: "memory")
#define PG8_WAIT_L(n) asm volatile("s_waitcnt lgkmcnt(" #n ")" ::: "memory")
#define PG8_BAR __builtin_amdgcn_s_barrier()
#define PG8_SCHED __builtin_amdgcn_sched_barrier(0)
    Unit cur, nxt; int ui = 0, ts = 0;
    if (!S.next(0, cur)) return;
    f32x4 acc[2][2][4][2];
#pragma unroll
    for (int a = 0; a < 2; ++a)
#pragma unroll
        for (int b = 0; b < 2; ++b)
#pragma unroll
            for (int m = 0; m < 4; ++m)
#pragma unroll
                for (int n = 0; n < 2; ++n) acc[a][b][m][n] = (f32x4){0.f, 0.f, 0.f, 0.f};
    bf16x8 At[4][2], B0[2][2], B1[2][2];
    const char* cA = (const char*)g.A + (size_t)cur.pm * tstepA; const char* cB = (const char*)g.Bt + (size_t)cur.pn * tstepB;
    if constexpr (SP2) {
        PG8_STAGE(PG8_SB(0, 0), cB, voffB); PG8_STAGE(PG8_SB(0, 1), cB + hstepB, voffB); PG8_STAGE(PG8_SA(0, 0), cA + AM(0), voffA); PG8_STAGE(PG8_SA(0, 1), cA + AM(0) + hstepA, voffA);
        if constexpr (Epi::HAS_PREP) { int lastpm = -1, slot = -1; for (int i = 0; S.next(i, nxt); ++i) if (nxt.pm != lastpm) { lastpm = nxt.pm; ++slot; E.prep(lds, slot, nxt, tid); } asm volatile("s_waitcnt lgkmcnt(0)" ::: "memory"); }
        if (wr == 1) PG8_BAR;
        PG8_WAIT_V(2); PG8_BAR;
        PG8_STAGE(PG8_SB(1, 0), cB + kstep, voffB); PG8_STAGE(PG8_SA(1, 0), cA + AM(1), voffA); PG8_STAGE(PG8_SB(1, 1), cB + hstepB + kstep, voffB);
        PG8_WAIT_V(6); PG8_BAR;
    } else {
        if constexpr (Epi::HAS_PREP) { int lastpm = -1, slot = -1; for (int i = 0; S.next(i, nxt); ++i) if (nxt.pm != lastpm) { lastpm = nxt.pm; ++slot; E.prep(lds, slot, nxt, tid); } asm volatile("s_waitcnt lgkmcnt(0)" ::: "memory"); }
        PG8_STAGE(PG8_SB(0, 0), cB, voffB); PG8_STAGE(PG8_SA(0, 0), cA + AM(0), voffA); PG8_STAGE(PG8_SB(0, 1), cB + hstepB, voffB); PG8_STAGE(PG8_SA(0, 1), cA + AM(0) + hstepA, voffA);
        if (wr == 1) PG8_BAR;
        PG8_WAIT_V(4); PG8_BAR;
        PG8_STAGE(PG8_SB(1, 0), cB + kstep, voffB); PG8_STAGE(PG8_SA(1, 0), cA + AM(1), voffA); PG8_STAGE(PG8_SB(1, 1), cB + hstepB + kstep, voffB);
        PG8_WAIT_V(6); PG8_BAR;
    }
    for (;;) {
        const bool has_next = S.next(ui + 1, nxt);
        if constexpr (Epi::HAS_COLTAB) { if (wid < 4) __builtin_amdgcn_global_load_lds((const unsigned*)(E.cs + cur.pn * BM + tid), (PG8_LAS unsigned*)(lds + CFTAB_OFF + (ui & 1) * 1024 + wid * 256), 4, 0, 0); }
        const char* nA = has_next ? (const char*)g.A + (size_t)nxt.pm * tstepA : cA; const char* nB = has_next ? (const char*)g.Bt + (size_t)nxt.pn * tstepB : cB;
        for (int t = 0; t < nt; t += 2) {
            const bool last = (t == nt - 2);
            const char* a1 = cA + AM(t + 1);
            const char* a2 = last ? nA + AM(0) : cA + AM(t + 2); const char* b2 = last ? nB : cB + (size_t)(t + 2) * kstep;
            const char* a3 = last ? nA + AM(1) : cA + AM(t + 3); const char* b3 = b2 + kstep;
            if constexpr (SP2) {
            PG8_LDB(B0, 0, 0); PG8_LDB(B1, 0, 1); PG8_SCHED; PG8_LDA(At, 0, 0); PG8_STAGE(PG8_SA(1, 1), a1 + hstepA, voffA);
            PG8_WAIT_V(8); PG8_WAIT_L(0); PG8_BAR; PG8_MMA(0, 0, At, B0); PG8_MMA(0, 1, At, B1); PG8_BAR; PG8_SCHED;
            PG8_LDA(At, 0, 1); PG8_STAGE(PG8_SB(0, 0), b2, voffB); PG8_STAGE(PG8_SB(0, 1), b2 + hstepB, voffB); PG8_STAGE(PG8_SA(0, 0), a2, voffA);
            PG8_WAIT_V(8); PG8_WAIT_L(0); PG8_BAR; PG8_MMA(1, 0, At, B0); PG8_MMA(1, 1, At, B1); PG8_BAR; PG8_SCHED;
            PG8_LDB(B0, 1, 0); PG8_LDB(B1, 1, 1); PG8_SCHED; PG8_LDA(At, 1, 0); PG8_STAGE(PG8_SA(0, 1), a2 + hstepA, voffA);
            PG8_WAIT_V(8); PG8_WAIT_L(0); PG8_BAR; PG8_MMA(0, 0, At, B0); PG8_MMA(0, 1, At, B1); PG8_BAR; PG8_SCHED;
            PG8_LDA(At, 1, 1); PG8_STAGE(PG8_SB(1, 0), b3, voffB); PG8_STAGE(PG8_SB(1, 1), b3 + hstepB, voffB); PG8_STAGE(PG8_SA(1, 0), a3, voffA);
            PG8_WAIT_V(8); PG8_WAIT_L(0); PG8_BAR; PG8_MMA(1, 0, At, B0); PG8_MMA(1, 1, At, B1); PG8_BAR; PG8_SCHED;
            } else {
            PG8_LDB(B0, 0, 0); PG8_SCHED; PG8_LDA(At, 0, 0); PG8_STAGE(PG8_SA(1, 1), a1 + hstepA, voffA);
            PG8_WAIT_L(8); PG8_BAR; PG8_WAIT_L(0); PG8_MMA(0, 0, At, B0); PG8_BAR; PG8_SCHED;
            PG8_LDB(B1, 0, 1); PG8_STAGE(PG8_SB(0, 0), b2, voffB);
            PG8_BAR; PG8_WAIT_L(0); PG8_MMA(0, 1, At, B1); PG8_BAR;
            PG8_LDA(At, 0, 1); PG8_STAGE(PG8_SA(0, 0), a2, voffA);
            PG8_BAR; PG8_WAIT_L(0); PG8_MMA(1, 0, At, B0); PG8_BAR; PG8_SCHED;
            PG8_STAGE(PG8_SB(0, 1), b2 + hstepB, voffB);
            PG8_WAIT_V(6); PG8_BAR; PG8_MMA(1, 1, At, B1); PG8_BAR;
            PG8_LDB(B0, 1, 0); PG8_SCHED; PG8_LDA(At, 1, 0); PG8_STAGE(PG8_SA(0, 1), a2 + hstepA, voffA);
            PG8_WAIT_L(8); PG8_BAR; PG8_WAIT_L(0); PG8_MMA(0, 0, At, B0); PG8_BAR; PG8_SCHED;
            PG8_LDB(B1, 1, 1); PG8_STAGE(PG8_SB(1, 0), b3, voffB);
            PG8_BAR; PG8_WAIT_L(0); PG8_MMA(0, 1, At, B1); PG8_BAR;
            PG8_LDA(At, 1, 1); PG8_STAGE(PG8_SA(1, 0), a3, voffA);
            PG8_BAR; PG8_WAIT_L(0); PG8_MMA(1, 0, At, B0); PG8_BAR; PG8_SCHED;
            PG8_STAGE(PG8_SB(1, 1), b3 + hstepB, voffB);
            PG8_WAIT_V(6); PG8_BAR; PG8_MMA(1, 1, At, B1); PG8_BAR;
            }
            if constexpr (Epi::HAS_MID) { if (!last && ((t + 2) & 3) == 0) E.mid(acc, cur, (t + 2) >> 2, wr, wc, fr, fq); }
        }
        if constexpr (ALIGN_EPI) { if (wr == 0) PG8_BAR; }
        E(acc, cur, ui | (ts << 8), lds, wr, wc, fr, fq);
        if (!has_next) break;
#pragma unroll
        for (int a = 0; a < 2; ++a)
#pragma unroll
            for (int b = 0; b < 2; ++b)
#pragma unroll
                for (int m = 0; m < 4; ++m)
#pragma unroll
                    for (int n = 0; n < 2; ++n) acc[a][b][m][n] = (f32x4){0.f, 0.f, 0.f, 0.f};
        ts += (nxt.pm != cur.pm) ? 1 : 0; cur = nxt; cA = nA; cB = nB; ++ui;
        if constexpr (ALIGN_EPI) { if (wr == 1) PG8_BAR; }
    }
    PG8_WAIT_V(0);
    if constexpr (!ALIGN_EPI) { if (wr == 0) PG8_BAR; }
    PG8_BAR;
#undef PG8_SA
#undef PG8_SB
#undef PG8_STAGE
#undef PG8_LDA
#undef PG8_LDB
#undef PG8_MMA
#undef PG8_WAIT_V
#undef PG8_WAIT_L
#undef PG8_BAR
#undef PG8_SCHED
}

struct EpiProj {
    static constexpr bool PERM = true, HAS_MID = false, HAS_PREP = true, HAS_COLTAB = false;
    bf16_t* O; const float* ssq; float* IFB; const float* igb; const float* fgb;
    __device__ __forceinline__ void prep(PG8_LAS unsigned char* lds, int i, const Unit& u, int tid) const { if (tid < 256) *(PG8_LAS float*)(lds + RSTAB_OFF + (i * 256 + tid) * 4) = rstd_of(ssq + (size_t)(u.pm * BM + tid) * 16); }
    __device__ __forceinline__ void operator()(const f32x4 (&acc)[2][2][4][2], const Unit& u, int ui, PG8_LAS unsigned char* lds, int wr, int wc, int fr, int fq) const {
        const int row0 = u.pm * BM + wr * 64 + fr, col0 = u.pn * BM + wc * 32 + 8 * fq;
        float rs[2][4];
#pragma unroll
        for (int ai = 0; ai < 2; ++ai)
#pragma unroll
            for (int m = 0; m < 4; ++m) rs[ai][m] = *(const PG8_LAS float*)(lds + RSTAB_OFF + ((ui >> 8) * 256 + wr * 64 + fr + ai * HALF + m * 16) * 4);
        if (u.pn < 9) {
#pragma unroll
        for (int ai = 0; ai < 2; ++ai)
#pragma unroll
            for (int m = 0; m < 4; ++m) { bf16_t* rowp = O + (size_t)(row0 + ai * HALF + m * 16) * NP + col0; const float r = rs[ai][m];
#pragma unroll
                for (int bj = 0; bj < 2; ++bj) { const f32x4 v0 = acc[ai][bj][m][0] * r, v1 = acc[ai][bj][m][1] * r;
                    u32x4 w; w.x = cvtpk(v0[0], v0[1]); w.y = cvtpk(v0[2], v0[3]); w.z = cvtpk(v1[0], v1[1]); w.w = cvtpk(v1[2], v1[3]);
                    *(u32x4*)(rowp + bj * HALF) = w; } }
        } else if (wc == 0 && fq == 0) {
            const f32x4 bi = *(const f32x4*)igb, bf = *(const f32x4*)fgb;
#pragma unroll
            for (int ai = 0; ai < 2; ++ai)
#pragma unroll
                for (int m = 0; m < 4; ++m) { float* p = IFB + (size_t)(row0 + ai * HALF + m * 16) * 8; const float r = rs[ai][m];
                    const f32x4 vi = acc[ai][0][m][0] * r + bi; f32x4 vf = acc[ai][0][m][1] * r + bf;
#pragma unroll
                    for (int j = 0; j < 4; ++j) vf[j] = -softplus(-vf[j]);
                    *(f32x4*)p = vi; *(f32x4*)(p + 4) = vf; }
        }
    }
};
struct EpiGates {
    static constexpr bool PERM = true, HAS_MID = false, HAS_PREP = true, HAS_COLTAB = true;
    bf16_t* GT; const float* ssq; const float* qsinv; const float* cs;
    __device__ __forceinline__ void prep(PG8_LAS unsigned char* lds, int i, const Unit& u, int tid) const { if (tid < 256) { const size_t row = (size_t)(u.pm * BM + tid); *(PG8_LAS float*)(lds + RSTAB_OFF + (i * 256 + tid) * 4) = rstd_of(ssq + row * 16) * qsinv[row] * -1.4426950408889634f; } }
    __device__ __forceinline__ void operator()(const f32x4 (&acc)[2][2][4][2], const Unit& u, int ui, PG8_LAS unsigned char* lds, int wr, int wc, int fr, int fq) const {
        const int col0 = u.pn * BM + wc * 32 + 8 * fq;
        f32x4 cf[2][2];
#pragma unroll
        for (int bj = 0; bj < 2; ++bj)
#pragma unroll
            for (int n = 0; n < 2; ++n) cf[bj][n] = *(const PG8_LAS f32x4*)(lds + CFTAB_OFF + (ui & 1) * 1024 + (wc * 32 + 8 * fq + bj * HALF + 4 * n) * 4);
        u32x4* tp = (u32x4*)GT + ((size_t)(u.pm * 12 + u.pn) * 8) * 512 + ((wr * 4 + wc) * 64 + fq * 16 + fr);
#pragma unroll
        for (int ai = 0; ai < 2; ++ai)
#pragma unroll
            for (int m = 0; m < 4; ++m) { const float r = *(const PG8_LAS float*)(lds + RSTAB_OFF + ((ui >> 8) * 256 + wr * 64 + fr + ai * HALF + m * 16) * 4); unsigned q[4];
#pragma unroll
                for (int bj = 0; bj < 2; ++bj)
#pragma unroll
                    for (int n = 0; n < 2; ++n) { const i32x4 ia = __builtin_bit_cast(i32x4, acc[ai][bj][m][n]); const f32x4 cr = cf[bj][n] * r; unsigned w = 0u;
#define Q8(x) __builtin_amdgcn_rcpf(__builtin_fmaf(__builtin_amdgcn_exp2f(x), 1.f / 255.f, 1.f / 255.f))
                        w = __builtin_amdgcn_cvt_pk_u8_f32(Q8((float)ia[0] * cr[0]), 0, w); w = __builtin_amdgcn_cvt_pk_u8_f32(Q8((float)ia[1] * cr[1]), 1, w); w = __builtin_amdgcn_cvt_pk_u8_f32(Q8((float)ia[2] * cr[2]), 2, w); w = __builtin_amdgcn_cvt_pk_u8_f32(Q8((float)ia[3] * cr[3]), 3, w); q[bj * 2 + n] = w; }
#undef Q8
                u32x4 w4; w4.x = q[0]; w4.y = q[1]; w4.z = q[2]; w4.w = q[3];
                tp[(size_t)(ai * 4 + m) * 512] = w4; }
    }
};
struct EpiMerge {
    static constexpr bool PERM = true, HAS_MID = true, HAS_PREP = false, HAS_COLTAB = false;
    const bf16_t* GT; bf16_t* O;
    __device__ __forceinline__ static void ld8(const bf16_t* p, float (&g)[8]) { const u32x4 w = *(const u32x4*)p;
        g[0] = bflo(w.x); g[1] = bfhi(w.x); g[2] = bflo(w.y); g[3] = bfhi(w.y); g[4] = bflo(w.z); g[5] = bfhi(w.z); g[6] = bflo(w.w); g[7] = bfhi(w.w);
#pragma unroll
        for (int j = 0; j < 8; ++j) g[j] = fmaxf(g[j], 1e-20f); }
    __device__ __forceinline__ static void raw4(unsigned w, float (&g)[8], int o) {
        g[o + 0] = fmaxf((float)(w & 0xffu), 0.5f); g[o + 1] = fmaxf((float)((w >> 8) & 0xffu), 0.5f); g[o + 2] = fmaxf((float)((w >> 16) & 0xffu), 0.5f); g[o + 3] = fmaxf((float)(w >> 24), 0.5f); }
    __device__ __forceinline__ static void up4(unsigned w, float (&g)[8], int o) {
        g[o + 0] = fmaxf((float)(w & 0xffu), 0.5f) * (1.f / 255.f); g[o + 1] = fmaxf((float)((w >> 8) & 0xffu), 0.5f) * (1.f / 255.f);
        g[o + 2] = fmaxf((float)((w >> 16) & 0xffu), 0.5f) * (1.f / 255.f); g[o + 3] = fmaxf((float)(w >> 24), 0.5f) * (1.f / 255.f); }
    __device__ __forceinline__ void mid(f32x4 (&acc)[2][2][4][2], const Unit& u, int nb  , int wr, int wc, int fr, int fq) const {
        int lid = (wr * 4 + wc) * 64 + fq * 16 + fr;
        asm volatile("" : "+v"(lid));
        const u32x4* tp = (const u32x4*)GT + ((size_t)(u.pm * 12 + (nb - 1) * 4 + u.pn) * 8) * 512 + lid; const u32x4* tn = tp + (size_t)4 * 8 * 512;
        u32x4 wp[2][4], wn[2][4];
#pragma unroll
        for (int ai = 0; ai < 2; ++ai)
#pragma unroll
            for (int m = 0; m < 4; ++m) { const size_t o = (size_t)(ai * 4 + m) * 512; wp[ai][m] = tp[o]; wn[ai][m] = tn[o]; }
#pragma unroll
        for (int ai = 0; ai < 2; ++ai)
#pragma unroll
            for (int m = 0; m < 4; ++m) { float gp[8], gn[8];
                raw4(wp[ai][m].x, gp, 0); raw4(wp[ai][m].y, gp, 4); raw4(wn[ai][m].x, gn, 0); raw4(wn[ai][m].y, gn, 4);
#pragma unroll
                for (int j = 0; j < 4; ++j) { acc[ai][0][m][0][j] *= gp[j] * frcp(gn[j]); acc[ai][0][m][1][j] *= gp[4 + j] * frcp(gn[4 + j]); }
                raw4(wp[ai][m].z, gp, 0); raw4(wp[ai][m].w, gp, 4); raw4(wn[ai][m].z, gn, 0); raw4(wn[ai][m].w, gn, 4);
#pragma unroll
                for (int j = 0; j < 4; ++j) { acc[ai][1][m][0][j] *= gp[j] * frcp(gn[j]); acc[ai][1][m][1][j] *= gp[4 + j] * frcp(gn[4 + j]); } }
    }
    __device__ __forceinline__ void operator()(const f32x4 (&acc)[2][2][4][2], const Unit& u, int ui, PG8_LAS unsigned char* lds, int wr, int wc, int fr, int fq) const {
        const int row0 = u.pm * BM + wr * 64 + fr, col0 = u.pn * BM + wc * 32 + 8 * fq;
        const u32x4* tg = (const u32x4*)GT + ((size_t)(u.pm * 12 + 2 * 4 + u.pn) * 8) * 512 + ((wr * 4 + wc) * 64 + fq * 16 + fr);
        u32x4 wg[2][4];
#pragma unroll
        for (int ai = 0; ai < 2; ++ai)
#pragma unroll
            for (int m = 0; m < 4; ++m) wg[ai][m] = tg[(size_t)(ai * 4 + m) * 512];
#pragma unroll
        for (int ai = 0; ai < 2; ++ai)
#pragma unroll
            for (int m = 0; m < 4; ++m) { const size_t r = (size_t)(row0 + ai * HALF + m * 16);
#pragma unroll
                for (int bj = 0; bj < 2; ++bj) { float gl[8]; up4(bj ? wg[ai][m].z : wg[ai][m].x, gl, 0); up4(bj ? wg[ai][m].w : wg[ai][m].y, gl, 4);
                    const f32x4 v0 = acc[ai][bj][m][0], v1 = acc[ai][bj][m][1];
                    u32x4 w; w.x = cvtpk(v0[0] * gl[0], v0[1] * gl[1]); w.y = cvtpk(v0[2] * gl[2], v0[3] * gl[3]); w.z = cvtpk(v1[0] * gl[4], v1[1] * gl[5]); w.w = cvtpk(v1[2] * gl[6], v1[3] * gl[7]);
                    *(u32x4*)(O + r * D + col0 + bj * HALF) = w; } }
    }
};
template <bool A8OUT> struct EpiRes {
    static constexpr bool PERM = true, HAS_MID = false, HAS_PREP = A8OUT, HAS_COLTAB = false;
    const float* basef; const bf16_t* xr; bf16_t* xout; float* ssq; signed char* a8; float* qsinv; const float* ssqp;
    __device__ __forceinline__ void prep(PG8_LAS unsigned char* lds, int i, const Unit& u, int tid) const { if (a8 && tid < 256) *(PG8_LAS float*)(lds + RSTAB_OFF + (i * 256 + tid) * 4) = QCLIP * rstd_of(ssqp + (size_t)(u.pm * BM + tid) * 16); }
    __device__ __forceinline__ static void q8store(const f32x4& x0, const f32x4& x1, float qs, signed char* p) {
        constexpr float MAG = 12582912.f; unsigned t0[4], t1[4];
#pragma unroll
        for (int j = 0; j < 4; ++j) { t0[j] = __float_as_uint(__builtin_amdgcn_fmed3f(__builtin_fmaf(x0[j], qs, MAG), MAG - 127.f, MAG + 127.f)); t1[j] = __float_as_uint(__builtin_amdgcn_fmed3f(__builtin_fmaf(x1[j], qs, MAG), MAG - 127.f, MAG + 127.f)); }
        const unsigned lo = __builtin_amdgcn_perm(t0[1], t0[0], 0x0c0c0400u) | __builtin_amdgcn_perm(t0[3], t0[2], 0x04000c0cu);
        const unsigned hi = __builtin_amdgcn_perm(t1[1], t1[0], 0x0c0c0400u) | __builtin_amdgcn_perm(t1[3], t1[2], 0x04000c0cu);
        *(u32x2*)p = (u32x2){lo, hi}; }
    __device__ __forceinline__ void operator()(const f32x4 (&acc)[2][2][4][2], const Unit& u, int ui, PG8_LAS unsigned char* lds, int wr, int wc, int fr, int fq) const {
        const int row0 = u.pm * BM + wr * 64 + fr, col0 = u.pn * BM + wc * 32 + 8 * fq;
        u32x4 bw[8][2];
#define RES_LOAD(g) do { _Pragma("unroll") for (int bj = 0; bj < 2; ++bj) bw[g][bj] = *(const u32x4*)(xr + (size_t)(row0 + ((g) >> 2) * HALF + ((g) & 3) * 16) * D + col0 + bj * HALF); } while (0)
        RES_LOAD(0); RES_LOAD(1); RES_LOAD(2);
#pragma unroll
        for (int g = 0; g < 8; ++g) { const int ai = g >> 2, m = g & 3;
            if (g + 3 < 8) RES_LOAD(g + 3);
            const size_t r = (size_t)(row0 + ai * HALF + m * 16), off = r * D + col0; float sq = 0.f, qs = 0.f;
            if constexpr (A8OUT) { if (a8) qs = *(const PG8_LAS float*)(lds + RSTAB_OFF + ((ui >> 8) * 256 + wr * 64 + fr + ai * HALF + m * 16) * 4); }
#pragma unroll
            for (int bj = 0; bj < 2; ++bj) { const u32x4 b = bw[g][bj];
                const f32x4 x0 = (f32x4){bflo(b.x), bfhi(b.x), bflo(b.y), bfhi(b.y)} + acc[ai][bj][m][0], x1 = (f32x4){bflo(b.z), bfhi(b.z), bflo(b.w), bfhi(b.w)} + acc[ai][bj][m][1];
                sq += (x0[0] * x0[0] + x0[1] * x0[1]) + (x0[2] * x0[2] + x0[3] * x0[3]) + (x1[0] * x1[0] + x1[1] * x1[1]) + (x1[2] * x1[2] + x1[3] * x1[3]);
                u32x4 w; w.x = cvtpk(x0[0], x0[1]); w.y = cvtpk(x0[2], x0[3]); w.z = cvtpk(x1[0], x1[1]); w.w = cvtpk(x1[2], x1[3]);
                *(u32x4*)(xout + off + bj * HALF) = w;
                if constexpr (A8OUT) { if (a8) q8store(x0, x1, qs, a8 + r * 1024 + col0 + bj * HALF); } }
            if constexpr (A8OUT) { if (a8 && u.pn == 0 && wc == 0 && fq == 0) qsinv[r] = __builtin_amdgcn_rcpf(qs); }
            sq += __shfl_xor(sq, 16); sq += __shfl_xor(sq, 32);
            if (fq == 0) ssq[r * 16 + u.pn * 4 + wc] = sq; }
#undef RES_LOAD
    }
};
struct EpiFinal {
    static constexpr bool PERM = true, HAS_MID = false, HAS_PREP = false, HAS_COLTAB = false;
    const bf16_t* xr; float* out; float* slots; unsigned* cnt; const float* gv;
    __device__ __forceinline__ void operator()(f32x4 (&acc)[2][2][4][2], const Unit& u, int ui, PG8_LAS unsigned char* lds, int wr, int wc, int fr, int fq) const {
        const int row0 = u.pm * BM + wr * 64 + fr, col0 = u.pn * BM + wc * 32 + 8 * fq;
        u32x4 bw[8][2];
#define RES_LOAD(g) do { _Pragma("unroll") for (int bj = 0; bj < 2; ++bj) bw[g][bj] = *(const u32x4*)(xr + (size_t)(row0 + ((g) >> 2) * HALF + ((g) & 3) * 16) * D + col0 + bj * HALF); } while (0)
        RES_LOAD(0); RES_LOAD(1); RES_LOAD(2);
#pragma unroll
        for (int g = 0; g < 8; ++g) { const int ai = g >> 2, m = g & 3;
            if (g + 3 < 8) RES_LOAD(g + 3);
            const size_t r = (size_t)(row0 + ai * HALF + m * 16); float sq = 0.f;
#pragma unroll
            for (int bj = 0; bj < 2; ++bj) { const u32x4 b = bw[g][bj];
                const f32x4 x0 = (f32x4){bflo(b.x), bfhi(b.x), bflo(b.y), bfhi(b.y)} + acc[ai][bj][m][0], x1 = (f32x4){bflo(b.z), bfhi(b.z), bflo(b.w), bfhi(b.w)} + acc[ai][bj][m][1];
                sq += (x0[0] * x0[0] + x0[1] * x0[1]) + (x0[2] * x0[2] + x0[3] * x0[3]) + (x1[0] * x1[0] + x1[1] * x1[1]) + (x1[2] * x1[2] + x1[3] * x1[3]);
                acc[ai][bj][m][0] = x0; acc[ai][bj][m][1] = x1; }
            sq += __shfl_xor(sq, 16); sq += __shfl_xor(sq, 32);
            if (fq == 0) __hip_atomic_store(slots + r * 16 + u.pn * 4 + wc, sq, __ATOMIC_RELAXED, __HIP_MEMORY_SCOPE_AGENT); }
#undef RES_LOAD
        asm volatile("s_waitcnt vmcnt(0)" ::: "memory");
        unsigned* c = cnt + u.pm * 16;
        if (fr == 0 && fq == 0) (void)__hip_atomic_fetch_add(c, 1u, __ATOMIC_RELAXED, __HIP_MEMORY_SCOPE_AGENT);
        { unsigned sp = 0u; while (__hip_atomic_load(c, __ATOMIC_RELAXED, __HIP_MEMORY_SCOPE_AGENT) < 32u) { __builtin_amdgcn_s_sleep(2); if (++sp > (1u << 22)) break; } }
        asm volatile("" ::: "memory");
        f32x4 gq[2][2];
#pragma unroll
        for (int bj = 0; bj < 2; ++bj)
#pragma unroll
            for (int n = 0; n < 2; ++n) gq[bj][n] = *(const f32x4*)(gv + col0 + bj * HALF + 4 * n);
#pragma unroll
        for (int g = 0; g < 8; ++g) { const int ai = g >> 2, m = g & 3; const size_t r = (size_t)(row0 + ai * HALF + m * 16);
            const unsigned long long* sp = (const unsigned long long*)(slots + r * 16 + 4 * fq);
            const unsigned long long a = __hip_atomic_load(sp, __ATOMIC_RELAXED, __HIP_MEMORY_SCOPE_AGENT), b = __hip_atomic_load(sp + 1, __ATOMIC_RELAXED, __HIP_MEMORY_SCOPE_AGENT);
            float s = (__uint_as_float((unsigned)a) + __uint_as_float((unsigned)(a >> 32))) + (__uint_as_float((unsigned)b) + __uint_as_float((unsigned)(b >> 32)));
            s += __shfl_xor(s, 16); s += __shfl_xor(s, 32);
            const float rstd = 1.f / sqrtf(s * (1.f / D) + EPS);
#pragma unroll
            for (int bj = 0; bj < 2; ++bj)
#pragma unroll
                for (int n = 0; n < 2; ++n) *(f32x4*)(out + r * D + col0 + bj * HALF + 4 * n) = acc[ai][bj][m][n] * rstd * gq[bj][n]; }
    }
};
struct EpiSwiglu {
    static constexpr bool PERM = true, HAS_MID = false, HAS_PREP = true, HAS_COLTAB = true;
    bf16_t* H; const float* ssq; const float* qsinv; const float* cs;
    __device__ __forceinline__ void prep(PG8_LAS unsigned char* lds, int i, const Unit& u, int tid) const { if (tid < 256) { const size_t row = (size_t)(u.pm * BM + tid); *(PG8_LAS float*)(lds + RSTAB_OFF + (i * 256 + tid) * 4) = rstd_of(ssq + row * 16) * qsinv[row]; } }
    __device__ __forceinline__ void operator()(const f32x4 (&acc)[2][2][4][2], const Unit& u, int ui, PG8_LAS unsigned char* lds, int wr, int wc, int fr, int fq) const {
        const int row0 = u.pm * BM + wr * 64 + fr, col0 = u.pn * HALF + wc * 32 + 8 * fq, cc0 = u.pn * BM + wc * 32 + 8 * fq;
        f32x4 cf[2][2];
#pragma unroll
        for (int bj = 0; bj < 2; ++bj)
#pragma unroll
            for (int n = 0; n < 2; ++n) cf[bj][n] = *(const PG8_LAS f32x4*)(lds + CFTAB_OFF + (ui & 1) * 1024 + (wc * 32 + 8 * fq + bj * HALF + 4 * n) * 4);
#pragma unroll
        for (int ai = 0; ai < 2; ++ai)
#pragma unroll
            for (int m = 0; m < 4; ++m) { float o[8]; const float rs = *(const PG8_LAS float*)(lds + RSTAB_OFF + ((ui >> 8) * 256 + wr * 64 + fr + ai * HALF + m * 16) * 4);
#pragma unroll
                for (int n = 0; n < 2; ++n) { const i32x4 ig = __builtin_bit_cast(i32x4, acc[ai][0][m][n]), iu = __builtin_bit_cast(i32x4, acc[ai][1][m][n]); const f32x4 cg = cf[0][n] * rs, cu = cf[1][n] * rs;
#pragma unroll
                    for (int j = 0; j < 4; ++j) { const float gt = (float)ig[j] * cg[j], up = (float)iu[j] * cu[j]; o[4 * n + j] = gt * sigm(gt) * up; } }
                u32x4 w; w.x = cvtpk(o[0], o[1]); w.y = cvtpk(o[2], o[3]); w.z = cvtpk(o[4], o[5]); w.w = cvtpk(o[6], o[7]);
                *(u32x4*)(H + (size_t)(row0 + ai * HALF + m * 16) * FF + col0) = w; }
    }
};
}

typedef GAS unsigned gu32;
#define RLX_AGENT __ATOMIC_RELAXED, __HIP_MEMORY_SCOPE_AGENT
#define LDS_WAIT() asm volatile("s_waitcnt lgkmcnt(0)" ::: "memory")
#define VM_WAIT() asm volatile("s_waitcnt vmcnt(0)" ::: "memory")

#define XB_TMO      128
#define XB_XCNT(j)  (256  + 64 * (j))
#define XB_XSUB(j)  (1280 + 64 * (j))
#define XB_XGEN(j)  (2304 + 64 * (j))
#define XB_TOP      3328
#define XB_TOPGEN   3392
#define XCD_BAR_WORDS 3456
#define XB_SPIN_CAP (1u << 18)
__device__ __forceinline__ unsigned xb_ld(unsigned* p)              { return __hip_atomic_load(p, __ATOMIC_RELAXED, __HIP_MEMORY_SCOPE_AGENT); }
__device__ __forceinline__ unsigned xb_add(unsigned* p, unsigned v) { return __hip_atomic_fetch_add(p, v, __ATOMIC_RELAXED, __HIP_MEMORY_SCOPE_AGENT); }
__device__ __forceinline__ unsigned xb_xcc_id() { return (unsigned)__builtin_amdgcn_s_getreg((3 << 11) | 20) & 0xFu; }
#define XB_SPIN(cond, bar) do { unsigned _sp = 0; while (cond) { __builtin_amdgcn_s_sleep(1); \
    if ((++_sp & 255u) == 0u) { if (xb_ld(&(bar)[XB_TMO])) break; if (_sp > XB_SPIN_CAP) { atomicAdd(&(bar)[XB_TMO], 1u); break; } } } } while (0)
struct XcdBarrier { unsigned* bar; unsigned x; volatile LAS unsigned* st; };
__device__ __forceinline__ XcdBarrier xcd_barrier_post(unsigned* bar, volatile LAS unsigned* st) {
    XcdBarrier b; b.bar = bar; b.x = xb_xcc_id(); b.st = st;
    if (threadIdx.x == 0) (void)xb_add(&bar[XB_XCNT(b.x)], 1u);
    return b;
}
__device__ __forceinline__ void xcd_barrier_complete(unsigned* bar, unsigned x, unsigned& nloc, unsigned& nx) {
    const unsigned G = gridDim.x * gridDim.y * gridDim.z;
    unsigned sum, cnt, mine, sp = 0u;
    for (;;) {
        sum = 0u; cnt = 0u; mine = 0u;
#pragma unroll
        for (unsigned j = 0; j < 16; ++j) { const unsigned c = xb_ld(&bar[XB_XCNT(j)]); sum += c; cnt += (c > 0u) ? 1u : 0u; mine = (j == x) ? c : mine; }
        if (sum == G) break;
        __builtin_amdgcn_s_sleep(1);
        if ((++sp & 255u) == 0u) { if (xb_ld(&bar[XB_TMO])) break; if (sp > XB_SPIN_CAP) { atomicAdd(&bar[XB_TMO], 1u); break; } }
    }
    nloc = mine > 0u ? mine : 1u; nx = cnt > 0u ? cnt : 1u;
}
__device__ __forceinline__ void xcd_barrier(const XcdBarrier& b) {
    asm volatile("s_waitcnt vmcnt(0)" ::: "memory");
    __syncthreads();
    int tid_ = threadIdx.x; asm volatile("" : "+v"(tid_));
    if (tid_ == 0) {
        unsigned* bar = b.bar; unsigned bx_ = b.x;
        asm volatile("" : "+s"(bar), "+s"(bx_));
        __builtin_amdgcn_s_waitcnt(0);
        unsigned nloc = b.st[0], nx = b.st[1];
        if (nloc == 0u) { xcd_barrier_complete(bar, bx_, nloc, nx); b.st[0] = nloc; b.st[1] = nx; }
        const unsigned old = xb_add(&bar[XB_XSUB(bx_)], 1u);
        const unsigned gen = old / nloc;
        if (old + 1u == (gen + 1u) * nloc) {
            __builtin_amdgcn_fence(__ATOMIC_RELEASE, "agent");
            asm volatile("s_waitcnt vmcnt(0)" ::: "memory");
            const unsigned og = xb_add(&bar[XB_TOP], 1u);
            const unsigned tg = og / nx;
            if (og + 1u == (tg + 1u) * nx) xb_add(&bar[XB_TOPGEN], 1u);
            else XB_SPIN(xb_ld(&bar[XB_TOPGEN]) == tg, bar);
            __builtin_amdgcn_fence(__ATOMIC_ACQUIRE, "agent");
            xb_add(&bar[XB_XGEN(bx_)], 1u);
            asm volatile("s_waitcnt vmcnt(0)" ::: "memory");
        } else {
            XB_SPIN(xb_ld(&bar[XB_XGEN(bx_)]) == gen, bar);
            __builtin_amdgcn_fence(__ATOMIC_ACQUIRE, "agent");
            asm volatile("s_waitcnt vmcnt(0)" ::: "memory");
        }
    }
    __syncthreads();
}

constexpr int NWAVES = 8;
struct Frame {
    LAS unsigned char* lds;
    int tid0, wave, vcu, G;
    float* out; unsigned char* ws;
};
constexpr int PTR_OFF = LDSCTL_OFF + 128;
typedef const GAS float* gfp;
typedef const GAS f32x4* gf4p;
DI gfp inp(const Frame& F, int i) {
    unsigned a_ = (unsigned)(PTR_OFF + 8 * i); asm volatile("" : "+s"(a_));
    const v2u w = *(const LAS v2u*)(F.lds + a_);
    const unsigned long long p = ((unsigned long long)(unsigned)__builtin_amdgcn_readfirstlane((int)w.y) << 32) | (unsigned)__builtin_amdgcn_readfirstlane((int)w.x);
    return (gfp)p;
}
enum { I_X = 0, I_NMG, I_WIN, I_CLW, I_LWA, I_LBA, I_LWX, I_LBX, I_LAM, I_CMW, I_IGB, I_FGB, I_WOL, I_WOM, I_WOS, I_WO, I_NFG, I_WF1, I_WF2, I_FNG };

#define PHASE_IDS int tid = F.tid0; asm volatile("" : "+v"(tid)); const int lane = tid & 63
DI float wave_sum(float v) {
#pragma unroll
    for (int o = 1; o < 64; o <<= 1) v += __shfl_xor(v, o);
    return v;
}
DI float wave_max(float v) {
#pragma unroll
    for (int o = 1; o < 64; o <<= 1) v = fmaxf(v, __shfl_xor(v, o));
    return v;
}
DI unsigned short f2bf1(float x) { return (unsigned short)(cvtpk(x, 0.f) & 0xffffu); }
DI void unpack8(const v4u w, float (&x)[8]) { x[0] = bflo(w.x); x[1] = bfhi(w.x); x[2] = bflo(w.y); x[3] = bfhi(w.y); x[4] = bflo(w.z); x[5] = bfhi(w.z); x[6] = bflo(w.w); x[7] = bfhi(w.w); }
DI v4u pack8(const float (&x)[8]) { v4u w; w.x = cvtpk(x[0], x[1]); w.y = cvtpk(x[2], x[3]); w.z = cvtpk(x[4], x[5]); w.w = cvtpk(x[6], x[7]); return w; }

DI void tr_item(gfp src, int ld_src, bf16* dst, int ld_dst, LAS float* scr, int lane, gfp gain = nullptr) {
    f32x4 v[8]; float gk[8];
#pragma unroll
    for (int i = 0; i < 8; ++i) { v[i] = *(gf4p)(src + (size_t)((lane >> 3) + 8 * i) * ld_src + 4 * (lane & 7)); gk[i] = gain ? gain[(lane >> 3) + 8 * i] : 1.f; }
#pragma unroll
    for (int i = 0; i < 8; ++i) { LAS float* p = scr + ((lane >> 3) + 8 * i) * 33 + 4 * (lane & 7); p[0] = v[i].x * gk[i]; p[1] = v[i].y * gk[i]; p[2] = v[i].z * gk[i]; p[3] = v[i].w * gk[i]; }
    LDS_WAIT(); asm volatile("" ::: "memory");
    const int c = lane & 7;
#pragma unroll
    for (int j = 0; j < 4; ++j) { const int n = (lane >> 3) + 8 * j; const LAS float* s = scr + (8 * c) * 33 + n;
        v4u o; o.x = cvtpk(s[0 * 33], s[1 * 33]); o.y = cvtpk(s[2 * 33], s[3 * 33]); o.z = cvtpk(s[4 * 33], s[5 * 33]); o.w = cvtpk(s[6 * 33], s[7 * 33]);
        *(v4u*)(dst + (size_t)n * ld_dst + 8 * c) = o; }
    LDS_WAIT(); asm volatile("" ::: "memory");
}
DI void phase_weights(Frame& F, int l) {
    PHASE_IDS;
    LAS float* scr = (LAS float*)(F.lds + F.wave * 16384);
    const int gw = F.vcu * NWAVES + F.wave, NGW = F.G * NWAVES;
    unsigned char* wl = F.ws + WS_WL0 + (size_t)l * WS_WLSTRIDE;
    bf16* WIN = (bf16*)(wl + WO_WIN); bf16* WOUT = (bf16*)(wl + WO_WOUT); bf16* WO = (bf16*)(wl + WO_WO); bf16* WF1 = (bf16*)(wl + WO_WF1); bf16* WF2 = (bf16*)(wl + WO_WF2); bf16* LRUW = (bf16*)(wl + WO_LRUW);
    constexpr int N_WIN = 16 * 73, N_WOUT = 384, N_WO = 512, N_WF1 = 0  , N_WF2 = 44 * 32, N_LRU = 16;
    constexpr int NITEMS = N_WIN + N_WOUT + N_WO + N_WF1 + N_WF2 + N_LRU;
    for (int it = gw; it < NITEMS; it += NGW) {
        int r = it;
        if (r < N_WIN) { const int kb = r / 73, nb = r % 73, sc = (nb == 72) ? 1536 : 32 * nb + (32 * nb >= 1536 ? 8 : 0);
            tr_item(inp(F, I_WIN) + (size_t)l * D * IN_COLS + (size_t)(64 * kb) * IN_COLS + sc, IN_COLS, WIN + (size_t)(32 * nb) * D + 64 * kb, D, scr, lane, inp(F, I_NMG) + l * D + 64 * kb); continue; } r -= N_WIN;
        if (r < N_WOUT) { const int br = r / 128, rr = r % 128, kb = rr / 32, nb = rr % 32; gfp W = inp(F, br == 0 ? I_WOL : (br == 1 ? I_WOM : I_WOS));
            tr_item(W + (size_t)l * 256 * D + (size_t)(64 * kb) * D + 32 * nb, D, WOUT + (size_t)(32 * nb) * 768 + br * 256 + 64 * kb, 768, scr, lane); continue; } r -= N_WOUT;
        if (r < N_WO) { const int kb = r / 32, nb = r % 32;
            tr_item(inp(F, I_WO) + (size_t)l * D * D + (size_t)(64 * kb) * D + 32 * nb, D, WO + (size_t)(32 * nb) * D + 64 * kb, D, scr, lane); continue; } r -= N_WO;
        if (r < N_WF1) { const int kb = r / 176, nb = r % 176, pn = nb / 8, w = nb % 8, sc = (w < 4) ? 128 * pn + 32 * w : FF + 128 * pn + 32 * (w - 4);
            tr_item(inp(F, I_WF1) + (size_t)l * D * 2 * FF + (size_t)(64 * kb) * 2 * FF + sc, 2 * FF, WF1 + (size_t)(32 * nb) * D + 64 * kb, D, scr, lane, inp(F, I_NFG) + l * D + 64 * kb); continue; } r -= N_WF1;
        if (r < N_WF2) { const int kb = r / 32, nb = r % 32;
            tr_item(inp(F, I_WF2) + (size_t)l * FF * D + (size_t)(64 * kb) * D + 32 * nb, D, WF2 + (size_t)(32 * nb) * FF + 64 * kb, FF, scr, lane); continue; } r -= N_WF2;
        { const int gate = r / 8, g = (r / 2) % 4, nb = r % 2; gfp W = inp(F, gate ? I_LWX : I_LWA);
            tr_item(W + (size_t)l * 4 * 4096 + g * 4096 + 32 * nb, 64, LRUW + (size_t)((gate * 4 + g) * 64 + 32 * nb) * 64, 64, scr, lane); }
    }
}
DI void phase_w8(Frame& F) {
    PHASE_IDS;
    LAS float* scr = (LAS float*)(F.lds + F.wave * 16384); LAS float* CM = (LAS float*)(F.lds + 12288);
    for (int it = F.vcu; it < DEPTH * 272; it += F.G) {
        const int l = it / 272, ib = it % 272; const bool ffn = ib >= 96; const int nb = ffn ? ib - 96 : ib;
        const int ldw = ffn ? 2 * FF : IN_COLS;
        gfp src, gain; signed char* W8; float* CS;
        if (!ffn) { src = inp(F, I_WIN) + (size_t)l * D * IN_COLS + 2312 + 32 * nb; gain = inp(F, I_NMG) + l * D;
            W8 = (signed char*)(F.ws + WS_W8 + (size_t)l * 4 * MiB) + (size_t)(32 * nb) * 1024; CS = (float*)(F.ws + WS_W8 + (size_t)l * 4 * MiB + 3 * MiB) + 32 * nb; }
        else { const int pn = nb / 8, w = nb % 8, sc = (w < 4) ? 128 * pn + 32 * w : FF + 128 * pn + 32 * (w - 4);
            unsigned char* wl = F.ws + WS_WL0 + (size_t)l * WS_WLSTRIDE;
            src = inp(F, I_WF1) + (size_t)l * D * 2 * FF + sc; gain = inp(F, I_NFG) + l * D;
            W8 = (signed char*)(wl + WO_W8F) + (size_t)(32 * nb) * 1024; CS = (float*)(wl + WO_CSF) + 32 * nb; }
        f32x4 v[2][8]; float mx[4] = {0.f, 0.f, 0.f, 0.f};
#pragma unroll
        for (int h = 0; h < 2; ++h)
#pragma unroll
            for (int i = 0; i < 8; ++i) { const int k = 128 * F.wave + 64 * h + (lane >> 3) + 8 * i; v[h][i] = *(gf4p)(src + (size_t)k * ldw + 4 * (lane & 7)) * gain[k]; }
#pragma unroll
        for (int h = 0; h < 2; ++h)
#pragma unroll
            for (int i = 0; i < 8; ++i) { mx[0] = fmaxf(mx[0], fabsf(v[h][i].x)); mx[1] = fmaxf(mx[1], fabsf(v[h][i].y)); mx[2] = fmaxf(mx[2], fabsf(v[h][i].z)); mx[3] = fmaxf(mx[3], fabsf(v[h][i].w)); }
#pragma unroll
        for (int e = 0; e < 4; ++e) { mx[e] = fmaxf(mx[e], __shfl_xor(mx[e], 8)); mx[e] = fmaxf(mx[e], __shfl_xor(mx[e], 16)); mx[e] = fmaxf(mx[e], __shfl_xor(mx[e], 32)); }
        __syncthreads();
        if (lane < 8) { CM[F.wave * 32 + 4 * lane + 0] = mx[0]; CM[F.wave * 32 + 4 * lane + 1] = mx[1]; CM[F.wave * 32 + 4 * lane + 2] = mx[2]; CM[F.wave * 32 + 4 * lane + 3] = mx[3]; }
        __syncthreads();
        float sc[4];
#pragma unroll
        for (int e = 0; e < 4; ++e) { float m = 0.f;
#pragma unroll
            for (int w = 0; w < 8; ++w) m = fmaxf(m, CM[w * 32 + 4 * (lane & 7) + e]);
            m = fmaxf(m, 1e-30f); sc[e] = 127.f / m; if (F.wave == 0 && lane < 8) CS[4 * lane + e] = m * (1.f / 127.f); }
#pragma unroll
        for (int h = 0; h < 2; ++h) {
#pragma unroll
            for (int i = 0; i < 8; ++i) { LAS float* p = scr + ((lane >> 3) + 8 * i) * 33 + 4 * (lane & 7); p[0] = v[h][i].x * sc[0]; p[1] = v[h][i].y * sc[1]; p[2] = v[h][i].z * sc[2]; p[3] = v[h][i].w * sc[3]; }
            LDS_WAIT(); asm volatile("" ::: "memory");
#pragma unroll
            for (int c2 = 0; c2 < 2; ++c2) { const int id = lane + 64 * c2, n = id >> 2, kc = id & 3; unsigned w4[4];
#pragma unroll
                for (int q = 0; q < 4; ++q) { unsigned w = 0u;
#pragma unroll
                    for (int j = 0; j < 4; ++j) { const int qi = (int)rintf(scr[(16 * kc + 4 * q + j) * 33 + n]); w |= ((unsigned)qi & 0xffu) << (8 * j); }
                    w4[q] = w; }
                *(v4u*)(W8 + (size_t)n * 1024 + 128 * F.wave + 64 * h + 16 * kc) = (v4u){w4[0], w4[1], w4[2], w4[3]}; }
            LDS_WAIT(); asm volatile("" ::: "memory");
        }
    }
}
DI void phase_x0(Frame& F, gfp xsrc) {
    PHASE_IDS;
    const int gw = F.vcu * NWAVES + F.wave, NGW = F.G * NWAVES;
    bf16* XR = (bf16*)F.out; float* SSQ = (float*)(F.ws + WS_SSQ);
    for (int m = gw; m < M; m += NGW) {
        gf4p xr = (gf4p)(xsrc + (size_t)m * D) + lane;
        f32x4 v[4]; float s2 = 0.f;
#pragma unroll
        for (int j = 0; j < 4; ++j) { v[j] = xr[64 * j]; s2 += (v[j].x * v[j].x + v[j].y * v[j].y) + (v[j].z * v[j].z + v[j].w * v[j].w); }
        s2 = wave_sum(s2);
        v2u* o8 = (v2u*)(XR + (size_t)m * D) + lane;
#pragma unroll
        for (int j = 0; j < 4; ++j) { v2u w; w.x = cvtpk(v[j].x, v[j].y); w.y = cvtpk(v[j].z, v[j].w); o8[64 * j] = w; }
        if (lane < 16) SSQ[(size_t)m * 16 + lane] = (lane == 0) ? s2 : 0.f;
        {
            const float qs = QCLIP / sqrtf(s2 * (1.f / D) + EPS); unsigned* a8 = (unsigned*)(F.ws + WS_A8 + (size_t)m * 1024) + lane;
#pragma unroll
            for (int j = 0; j < 4; ++j) { const int q0 = (int)fminf(fmaxf(rintf(v[j].x * qs), -127.f), 127.f), q1 = (int)fminf(fmaxf(rintf(v[j].y * qs), -127.f), 127.f), q2 = (int)fminf(fmaxf(rintf(v[j].z * qs), -127.f), 127.f), q3 = (int)fminf(fmaxf(rintf(v[j].w * qs), -127.f), 127.f);
                a8[64 * j] = ((unsigned)q0 & 0xffu) | (((unsigned)q1 & 0xffu) << 8) | (((unsigned)q2 & 0xffu) << 16) | ((unsigned)q3 << 24); }
            if (lane == 0) ((float*)(F.ws + WS_QSINV))[m] = 1.f / qs; }
    }
}
DI void phase_final_norm(Frame& F, float* out, gfp gvec) {
    PHASE_IDS;
    const int gw = F.vcu * NWAVES + F.wave, NGW = F.G * NWAVES;
    f32x4 gv[4];
#pragma unroll
    for (int j = 0; j < 4; ++j) gv[j] = *((gf4p)gvec + lane + 64 * j);
    const float* SSQ = (const float*)(F.ws + WS_SSQ); const bf16* XF = (const bf16*)(F.ws + WS_XN);
    for (int m = gw; m < M; m += NGW) {
        f32x4* xr = (f32x4*)(out + (size_t)m * D) + lane; const v2u* xi = (const v2u*)(XF + (size_t)m * D) + lane;
        const float rstd = pg8::rstd_of(SSQ + (size_t)m * 16);
#pragma unroll
        for (int j = 0; j < 4; ++j) { const v2u w = xi[64 * j]; const f32x4 x = {bflo(w.x), bfhi(w.x), bflo(w.y), bfhi(w.y)}; xr[64 * j] = x * rstd * gv[j]; }
    }
}

DI void load_taps(const bf16* PROJ, int b, int pos, int col, v4u (&xk)[4]) {
#pragma unroll
    for (int k = 0; k < 4; ++k) { const int p = pos - 3 + k; xk[k] = (p >= 0) ? *(const v4u*)(PROJ + (size_t)(b * SEQ + p) * NP + col) : (v4u){0u, 0u, 0u, 0u}; }
}
constexpr int XA_PITCH = 528, LRU_GT_OFF = 128 * XA_PITCH;
static_assert(LRU_GT_OFF + 128 * XA_PITCH <= RSTAB_OFF, "LRU LDS map");
template <bool FINAL> DI void lru_item(Frame& F, int l, int b, int ci) {
    PHASE_IDS;
    bf16* PROJ = (bf16*)(F.ws + WS_PROJ); const bf16* LRUW = (const bf16*)(F.ws + WS_WL0 + (size_t)l * WS_WLSTRIDE + WO_LRUW); f32x2* LSUM = (f32x2*)(F.ws + WS_LSUM);
    LAS unsigned char* lds = F.lds;
    const int c8 = (tid & 31) * 8, t0 = tid >> 5;
    v4u gt[8];
    const int g = F.wave >> 1, jh = F.wave & 1, r = lane & 31, hh = lane >> 5, c = g * 64 + jh * 32 + r;
    bf16x8 wrf[4], wif[4];
#pragma unroll
    for (int ks = 0; ks < 4; ++ks) { wrf[ks] = *(const bf16x8*)(LRUW + (size_t)((0 * 4 + g) * 64 + jh * 32 + r) * 64 + 16 * ks + 8 * hh); wif[ks] = *(const bf16x8*)(LRUW + (size_t)((1 * 4 + g) * 64 + jh * 32 + r) * 64 + 16 * ks + 8 * hh); }
    const float ba = inp(F, I_LBA)[l * 256 + c], bx = inp(F, I_LBX)[l * 256 + c], lam = inp(F, I_LAM)[l * 256 + c];
    v4u xk[2][4][4];
#pragma unroll
    for (int hb = 0; hb < 2; ++hb)
#pragma unroll
        for (int i = 0; i < 4; ++i) load_taps(PROJ, b, ci * LCH + t0 + 16 * (4 * hb + i), C_LX + c8, xk[hb][i]);
    __syncthreads();
    {
        gfp cw = inp(F, I_CLW) + l * 1024 + c8;
#pragma unroll
        for (int hb = 0; hb < 2; ++hb) {
#pragma unroll
            for (int i = 0; i < 4; ++i) { float acc[8];
#pragma unroll
                for (int e = 0; e < 8; ++e) acc[e] = 0.f;
#pragma unroll
                for (int k = 0; k < 4; ++k) { float x[8]; unpack8(xk[hb][i][k], x); const f32x4 wa = *(gf4p)(cw + k * 256), wb = *(gf4p)(cw + k * 256 + 4);
                    acc[0] += wa.x * x[0]; acc[1] += wa.y * x[1]; acc[2] += wa.z * x[2]; acc[3] += wa.w * x[3]; acc[4] += wb.x * x[4]; acc[5] += wb.y * x[5]; acc[6] += wb.z * x[6]; acc[7] += wb.w * x[7]; }
                *(LAS v4u*)(lds + (t0 + 16 * (4 * hb + i)) * XA_PITCH + c8 * 2) = pack8(acc); } }
    }
    if (FINAL) {
#pragma unroll
        for (int i = 0; i < 8; ++i) gt[i] = *(const v4u*)(PROJ + (size_t)(b * SEQ + ci * LCH + t0 + 16 * i) * NP + C_LG + c8);
    }
    if (FINAL) {
        const int j0 = (ci * F.wave) / 8, j1 = (ci * (F.wave + 1)) / 8;
        float A[4] = {1.f, 1.f, 1.f, 1.f}, Bv[4] = {0.f, 0.f, 0.f, 0.f};
        for (int j = j0; j < j1; j += 8) { f32x2 sm[8][4];
#pragma unroll
            for (int jj = 0; jj < 8; ++jj) { const int jc = (j + jj < j1) ? j + jj : j1 - 1;
#pragma unroll
                for (int q = 0; q < 4; ++q) sm[jj][q] = LSUM[(size_t)(b * NLCH + jc) * 256 + lane + 64 * q]; }
#pragma unroll
            for (int jj = 0; jj < 8; ++jj) if (j + jj < j1) {
#pragma unroll
                for (int q = 0; q < 4; ++q) { Bv[q] = sm[jj][q].x * Bv[q] + sm[jj][q].y; A[q] *= sm[jj][q].x; } } }
#pragma unroll
        for (int q = 0; q < 4; ++q) *(LAS f32x2*)(lds + LRU_GT_OFF + (F.wave * 256 + lane + 64 * q) * 8) = (f32x2){A[q], Bv[q]};
    }
    __syncthreads();
    const float sp8 = 8.f * softplus(-lam);
    float carry = 0.f, Atot = 1.f;
    if (FINAL) {
#pragma unroll
        for (int w = 0; w < 8; ++w) { const f32x2 p = *(const LAS f32x2*)(lds + LRU_GT_OFF + (w * 256 + c) * 8); carry = p.x * carry + p.y; }
        __syncthreads();
#pragma unroll
        for (int i = 0; i < 8; ++i) *(LAS v4u*)(lds + LRU_GT_OFF + (t0 + 16 * i) * XA_PITCH + c8 * 2) = gt[i];
        __syncthreads();
    }
    for (int tt = 0; tt < 4; ++tt) {
        f32x16 accr, acci;
#pragma unroll
        for (int i = 0; i < 16; ++i) { accr[i] = 0.f; acci[i] = 0.f; }
#pragma unroll
        for (int ks = 0; ks < 4; ++ks) { const bf16x8 a = *(const LAS bf16x8*)(lds + (tt * 32 + tau(r)) * XA_PITCH + (g * 64 + 16 * ks + 8 * hh) * 2); accr = MFMA32(a, wrf[ks], accr); acci = MFMA32(a, wif[ks], acci); }
        float HL[16], PP[16]; float hl = 0.f, pp = 1.f;
#pragma unroll
        for (int reg = 0; reg < 16; ++reg) {
            const float xv = bf2f(*(const LAS unsigned short*)(lds + (tt * 32 + 16 * hh + reg) * XA_PITCH + c * 2));
            const float rg = sigm(accr[reg] + ba), ig = sigm(acci[reg] + bx), la = -sp8 * rg, a = fexp(la), u = __builtin_amdgcn_sqrtf(fmaxf(1.f - a * a, 0.f)) * ig * xv;
            hl = a * hl + u; pp = pp * a; HL[reg] = hl; PP[reg] = pp; }
        const float e0h = __shfl(hl, r), e0p = __shfl(pp, r), e1h = __shfl(hl, r + 32), e1p = __shfl(pp, r + 32);
        const float end0 = e0h + e0p * carry, end1 = e1h + e1p * end0, enter = hh ? end0 : carry;
        carry = end1; Atot *= e0p * e1p;
        if (FINAL) {
#pragma unroll
            for (int reg = 0; reg < 16; ++reg) { const float hv = HL[reg] + PP[reg] * enter; LAS unsigned short* gp = (LAS unsigned short*)(lds + LRU_GT_OFF + (tt * 32 + 16 * hh + reg) * XA_PITCH + c * 2);
                *gp = f2bf1(hv * gelu_tanh(bf2f(*gp))); }
        }
    }
    if (!FINAL) { if (hh == 0) LSUM[(size_t)(b * NLCH + ci) * 256 + c] = (f32x2){Atot, carry}; }
    else {
        __syncthreads();
#pragma unroll
        for (int i = 0; i < 8; ++i) { const size_t row = (size_t)(b * SEQ + ci * LCH + t0 + 16 * i);
            *(v4u*)(PROJ + row * NP + C_LG + c8) = *(const LAS v4u*)(lds + LRU_GT_OFF + (t0 + 16 * i) * XA_PITCH + c8 * 2); }
    }
}

constexpr int CW_LRU = 12288;
DI void lru_item_sp(Frame& F, int l, int b, int ci) {
    PHASE_IDS;
    bf16* PROJ = (bf16*)(F.ws + WS_PROJ); const bf16* LRUW = (const bf16*)(F.ws + WS_WL0 + (size_t)l * WS_WLSTRIDE + WO_LRUW);
    unsigned long long* LSUM = (unsigned long long*)(F.ws + WS_LSUM); unsigned* LCNT = (unsigned*)(F.ws + WS_CTL) + CW_LRU;
    LAS unsigned char* lds = F.lds;
    const int c8 = (tid & 31) * 8, t0 = tid >> 5;
    const int g = F.wave >> 1, jh = F.wave & 1, r = lane & 31, hh = lane >> 5, c = g * 64 + jh * 32 + r;
    bf16x8 wrf[4], wif[4];
#pragma unroll
    for (int ks = 0; ks < 4; ++ks) { wrf[ks] = *(const bf16x8*)(LRUW + (size_t)((0 * 4 + g) * 64 + jh * 32 + r) * 64 + 16 * ks + 8 * hh); wif[ks] = *(const bf16x8*)(LRUW + (size_t)((1 * 4 + g) * 64 + jh * 32 + r) * 64 + 16 * ks + 8 * hh); }
    const float ba = inp(F, I_LBA)[l * 256 + c], bx = inp(F, I_LBX)[l * 256 + c], lam = inp(F, I_LAM)[l * 256 + c];
    v4u xk[2][4][4];
#pragma unroll
    for (int hb = 0; hb < 2; ++hb)
#pragma unroll
        for (int i = 0; i < 4; ++i) load_taps(PROJ, b, ci * LCH + t0 + 16 * (4 * hb + i), C_LX + c8, xk[hb][i]);
    __syncthreads();
    {
        gfp cw = inp(F, I_CLW) + l * 1024 + c8;
#pragma unroll
        for (int hb = 0; hb < 2; ++hb) {
#pragma unroll
            for (int i = 0; i < 4; ++i) { float acc[8];
#pragma unroll
                for (int e = 0; e < 8; ++e) acc[e] = 0.f;
#pragma unroll
                for (int k = 0; k < 4; ++k) { float x[8]; unpack8(xk[hb][i][k], x); const f32x4 wa = *(gf4p)(cw + k * 256), wb = *(gf4p)(cw + k * 256 + 4);
                    acc[0] += wa.x * x[0]; acc[1] += wa.y * x[1]; acc[2] += wa.z * x[2]; acc[3] += wa.w * x[3]; acc[4] += wb.x * x[4]; acc[5] += wb.y * x[5]; acc[6] += wb.z * x[6]; acc[7] += wb.w * x[7]; }
                *(LAS v4u*)(lds + (t0 + 16 * (4 * hb + i)) * XA_PITCH + c8 * 2) = pack8(acc); } }
    }
    {
        v4u gt[8];
#pragma unroll
        for (int i = 0; i < 8; ++i) gt[i] = *(const v4u*)(PROJ + (size_t)(b * SEQ + ci * LCH + t0 + 16 * i) * NP + C_LG + c8);
#pragma unroll
        for (int i = 0; i < 8; ++i) *(LAS v4u*)(lds + LRU_GT_OFF + (t0 + 16 * i) * XA_PITCH + c8 * 2) = gt[i];
    }
    __syncthreads();
    const float sp8 = 8.f * softplus(-lam);
    float HL[4][16], EH0[4], EP0[4], EH1[4], EP1[4]; unsigned PPk[4][8];
    float carry = 0.f, Atot = 1.f;
#pragma unroll
    for (int tt = 0; tt < 4; ++tt) {
        f32x16 accr, acci;
#pragma unroll
        for (int i = 0; i < 16; ++i) { accr[i] = 0.f; acci[i] = 0.f; }
#pragma unroll
        for (int ks = 0; ks < 4; ++ks) { const bf16x8 a = *(const LAS bf16x8*)(lds + (tt * 32 + tau(r)) * XA_PITCH + (g * 64 + 16 * ks + 8 * hh) * 2); accr = MFMA32(a, wrf[ks], accr); acci = MFMA32(a, wif[ks], acci); }
        float hl = 0.f, pp = 1.f, ppv[16];
#pragma unroll
        for (int reg = 0; reg < 16; ++reg) {
            const float xv = bf2f(*(const LAS unsigned short*)(lds + (tt * 32 + 16 * hh + reg) * XA_PITCH + c * 2));
            const float rg = sigm(accr[reg] + ba), ig = sigm(acci[reg] + bx), la = -sp8 * rg, a = fexp(la), u = __builtin_amdgcn_sqrtf(fmaxf(1.f - a * a, 0.f)) * ig * xv;
            hl = a * hl + u; pp = pp * a; HL[tt][reg] = hl; ppv[reg] = pp; }
#pragma unroll
        for (int q = 0; q < 8; ++q) PPk[tt][q] = cvtpk(ppv[2 * q], ppv[2 * q + 1]);
        const float e0h = __shfl(hl, r), e0p = __shfl(pp, r), e1h = __shfl(hl, r + 32), e1p = __shfl(pp, r + 32);
        EH0[tt] = e0h; EP0[tt] = e0p; EH1[tt] = e1h; EP1[tt] = e1p;
        const float end0 = e0h + e0p * carry, end1 = e1h + e1p * end0;
        carry = end1; Atot *= e0p * e1p;
    }
    if (hh == 0) __hip_atomic_store(LSUM + (size_t)(b * NLCH + ci) * 256 + c, ((unsigned long long)__float_as_uint(carry) << 32) | __float_as_uint(Atot), __ATOMIC_RELAXED, __HIP_MEMORY_SCOPE_AGENT);
    asm volatile("s_waitcnt vmcnt(0)" ::: "memory");
    if (lane == 0) (void)__hip_atomic_fetch_add(LCNT + (b * NLCH + ci) * 4, 1u, __ATOMIC_RELAXED, __HIP_MEMORY_SCOPE_AGENT);
    __syncthreads();
    {
        const int j0 = (ci * F.wave) / 8, j1 = (ci * (F.wave + 1)) / 8; const unsigned target = 8u * (unsigned)(l + 1);
        if (lane < j1 - j0) { unsigned* cp = LCNT + (b * NLCH + j0 + lane) * 4; unsigned sp = 0u;
            while (__hip_atomic_load(cp, __ATOMIC_RELAXED, __HIP_MEMORY_SCOPE_AGENT) < target) { __builtin_amdgcn_s_sleep(1); if (++sp > (1u << 22)) break; } }
        asm volatile("" ::: "memory");
        float A[4] = {1.f, 1.f, 1.f, 1.f}, Bv[4] = {0.f, 0.f, 0.f, 0.f};
        for (int j = j0; j < j1; j += 8) { unsigned long long sm[8][4];
#pragma unroll
            for (int jj = 0; jj < 8; ++jj) { const int jc = (j + jj < j1) ? j + jj : j1 - 1;
#pragma unroll
                for (int q = 0; q < 4; ++q) sm[jj][q] = __hip_atomic_load(LSUM + (size_t)(b * NLCH + jc) * 256 + lane + 64 * q, __ATOMIC_RELAXED, __HIP_MEMORY_SCOPE_AGENT); }
#pragma unroll
            for (int jj = 0; jj < 8; ++jj) if (j + jj < j1) {
#pragma unroll
                for (int q = 0; q < 4; ++q) { const float sa = __uint_as_float((unsigned)sm[jj][q]), sb = __uint_as_float((unsigned)(sm[jj][q] >> 32)); Bv[q] = sa * Bv[q] + sb; A[q] *= sa; } } }
#pragma unroll
        for (int q = 0; q < 4; ++q) *(LAS f32x2*)(lds + (F.wave * 256 + lane + 64 * q) * 8) = (f32x2){A[q], Bv[q]};
    }
    __syncthreads();
    carry = 0.f;
#pragma unroll
    for (int w = 0; w < 8; ++w) { const f32x2 p = *(const LAS f32x2*)(lds + (w * 256 + c) * 8); carry = p.x * carry + p.y; }
#pragma unroll
    for (int tt = 0; tt < 4; ++tt) {
        const float end0 = EH0[tt] + EP0[tt] * carry, end1 = EH1[tt] + EP1[tt] * end0, enter = hh ? end0 : carry;
        carry = end1;
#pragma unroll
        for (int reg = 0; reg < 16; ++reg) { const unsigned pw = PPk[tt][reg >> 1]; const float hv = HL[tt][reg] + ((reg & 1) ? bfhi(pw) : bflo(pw)) * enter; LAS unsigned short* gp = (LAS unsigned short*)(lds + LRU_GT_OFF + (tt * 32 + 16 * hh + reg) * XA_PITCH + c * 2);
            *gp = f2bf1(hv * gelu_tanh(bf2f(*gp))); }
    }
    __syncthreads();
    int t0s = t0; asm volatile("" : "+v"(t0s));
#pragma unroll
    for (int i = 0; i < 8; ++i) { const size_t row = (size_t)(b * SEQ + ci * LCH + t0s + 16 * i);
        *(v4u*)(PROJ + row * NP + C_LG + c8) = *(const LAS v4u*)(lds + LRU_GT_OFF + (t0s + 16 * i) * XA_PITCH + c8 * 2); }
}

DI float scan_add(float x, int lane) {
#pragma unroll
    for (int o = 1; o < 64; o <<= 1) { const float t = __shfl_up(x, o); if (lane >= o) x += t; }
    return x;
}
DI float scan_max(float x, int lane) {
#pragma unroll
    for (int o = 1; o < 64; o <<= 1) { const float t = __shfl_up(x, o); if (lane >= o) x = fmaxf(x, t); }
    return x;
}
DI void conv8_silu(const bf16* PROJ, int b, int pos, int col, const float (&w)[4][8], float scale, float (&o)[8]) {
#pragma unroll
    for (int e = 0; e < 8; ++e) o[e] = 0.f;
#pragma unroll
    for (int k = 0; k < 4; ++k) { const int p = pos - 3 + k; if (p >= 0) { float x[8]; unpack8(*(const v4u*)(PROJ + (size_t)(b * SEQ + p) * NP + col), x);
#pragma unroll
        for (int e = 0; e < 8; ++e) o[e] += w[k][e] * x[e]; } }
#pragma unroll
    for (int e = 0; e < 8; ++e) o[e] = siluf(o[e]) * scale;
}
DI void load_cw(gfp cw, float (&w)[4][8]) {
#pragma unroll
    for (int k = 0; k < 4; ++k) { const f32x4 a = *(gf4p)(cw + k * 512), c = *(gf4p)(cw + k * 512 + 4);
        w[k][0] = a.x; w[k][1] = a.y; w[k][2] = a.z; w[k][3] = a.w; w[k][4] = c.x; w[k][5] = c.y; w[k][6] = c.z; w[k][7] = c.w; }
}
DI void conv8_regs(const v4u (&xk)[4], gfp cw  , float scale, float (&o)[8]) {
#pragma unroll
    for (int e = 0; e < 8; ++e) o[e] = 0.f;
#pragma unroll
    for (int k = 0; k < 4; ++k) { float x[8]; unpack8(xk[k], x); const f32x4 a = *(gf4p)(cw + k * 512), c = *(gf4p)(cw + k * 512 + 4);
        o[0] += a.x * x[0]; o[1] += a.y * x[1]; o[2] += a.z * x[2]; o[3] += a.w * x[3]; o[4] += c.x * x[4]; o[5] += c.y * x[5]; o[6] += c.z * x[6]; o[7] += c.w * x[7]; }
#pragma unroll
    for (int e = 0; e < 8; ++e) o[e] = siluf(o[e]) * scale;
}
#define GATHER8(dst, base, pitch, col, ROWEXPR) do { unsigned g_[8]; _Pragma("unroll") for (int j = 0; j < 8; ++j) g_[j] = *(const LAS unsigned short*)((base) + (ROWEXPR) * (pitch) + (col) * 2); \
    v4u w_; w_.x = g_[0] | (g_[1] << 16); w_.y = g_[2] | (g_[3] << 16); w_.z = g_[4] | (g_[5] << 16); w_.w = g_[6] | (g_[7] << 16); dst = __builtin_bit_cast(bf16x8, w_); } while (0)
constexpr int M1_HB = 20480;
DI void m1_item(Frame& F, int l, int b, int cm) {
    PHASE_IDS;
    const bf16* PROJ = (const bf16*)(F.ws + WS_PROJ); const float* IFB = (const float*)(F.ws + WS_IF);
    float* BL = (float*)(F.ws + WS_MSC); float* GG = BL + 2048; float* MST = (float*)(F.ws + WS_MST); float* MSN = (float*)(F.ws + WS_MSN);
    LAS unsigned char* lds = F.lds;
    const int hd = F.wave >> 1, sub = F.wave & 1, r = lane & 31, hh = lane >> 5;
    const int c8i = tid & 31, cc = c8i * 8, head = c8i >> 3, d0 = (c8i & 7) * 8, s0 = tid >> 5;
    v4u xk[4][4], xv[4];
#pragma unroll
    for (int i = 0; i < 4; ++i) { const int pos = cm * MCH + s0 + 16 * i; load_taps(PROJ, b, pos, C_MK + cc, xk[i]); xv[i] = *(const v4u*)(PROJ + (size_t)(b * SEQ + pos) * NP + C_MV + cc); }
    float ip = 0.f, lf = 0.f;
    if (sub == 0) { const size_t row = (size_t)b * SEQ + cm * MCH + lane; ip = IFB[row * 8 + hd]; lf = IFB[row * 8 + 4 + hd]; }
    __syncthreads();
    if (sub == 0) {
        const float bs = scan_add(lf, lane), bL = __shfl(bs, 63), gs = bL - bs + ip, G = wave_max(gs);
        *(LAS float*)(lds + hd * M1_HB + 18432 + lane * 4) = fexp(gs - G);
        if (lane == 0) { BL[(b * 4 + hd) * NMCH + cm] = bL; GG[(b * 4 + hd) * NMCH + cm] = G; }
    }
    { gfp cw = inp(F, I_CMW) + l * 2048 + 256 + cc; LAS unsigned char* hbs = lds + head * M1_HB;
#pragma unroll
      for (int i = 0; i < 4; ++i) { float kv[8]; conv8_regs(xk[i], cw, 0.125f, kv); *(LAS v4u*)(hbs + (s0 + 16 * i) * 144 + d0 * 2) = pack8(kv); } }
    __syncthreads();
    { LAS unsigned char* hbs = lds + head * M1_HB;
#pragma unroll
      for (int i = 0; i < 4; ++i) { const int sidx = s0 + 16 * i; const float ws = *(const LAS float*)(hbs + 18432 + sidx * 4); float vv[8]; unpack8(xv[i], vv);
#pragma unroll
        for (int e = 0; e < 8; ++e) vv[e] *= ws;
        *(LAS v4u*)(hbs + 9216 + sidx * 144 + d0 * 2) = pack8(vv); } }
    __syncthreads();
    {
        LAS unsigned char* hb = lds + hd * M1_HB; const int vt = sub; const size_t base = ((size_t)(b * 4 + hd) * NMCH + cm) * 4096;
        bf16x8 af[4];
#pragma unroll
        for (int ks = 0; ks < 4; ++ks) GATHER8(af[ks], hb + 9216, 144, vt * 32 + r, (16 * ks + 8 * hh + j));
#pragma unroll
        for (int kt = 0; kt < 2; ++kt) { f32x16 acc;
#pragma unroll
            for (int i = 0; i < 16; ++i) acc[i] = 0.f;
#pragma unroll
            for (int ks = 0; ks < 4; ++ks) { bf16x8 bb; GATHER8(bb, hb, 144, kt * 32 + r, (16 * ks + 8 * hh + j)); acc = MFMA32(af[ks], bb, acc); }
#pragma unroll
            for (int reg = 0; reg < 16; ++reg) MST[base + (size_t)(vt * 32 + crow(reg, hh)) * 64 + kt * 32 + r] = acc[reg]; }
        if (tid < 256) { const int hd2 = tid >> 6, k = tid & 63; LAS unsigned char* h2 = lds + hd2 * M1_HB; float sm = 0.f;
#pragma unroll 8
            for (int sidx = 0; sidx < 64; ++sidx) sm += bf2f(*(const LAS unsigned short*)(h2 + sidx * 144 + k * 2)) * *(const LAS float*)(h2 + 18432 + sidx * 4);
            MSN[((size_t)(b * 4 + hd2) * NMCH + cm) * 64 + k] = sm; }
    }
}
DI void m2_scan(Frame& F) {
    PHASE_IDS;
    LAS unsigned char* lds = F.lds;
    LAS float* TH = (LAS float*)lds; LAS float* MM = TH + 256; LAS float* WA = MM + 272; LAS float* WB = WA + 256; LAS float* WT = WB + 256; LAS float* TT = WT + 256;
    const int bh = F.vcu >> 5, e0 = (F.vcu & 31) * 130;
    if (F.vcu >= 256) return;
    const float* BLp = (const float*)(F.ws + WS_MSC) + bh * NMCH; const float* GGp = BLp + 2048; float* MAp = (float*)(F.ws + WS_MSC) + 4096 + bh * NMCH;
    __syncthreads();
    if (F.wave == 0) {
        float bl[4], gg[4], bi[4]; float tot = 0.f;
#pragma unroll
        for (int i = 0; i < 4; ++i) { bl[i] = BLp[4 * lane + i]; gg[i] = GGp[4 * lane + i]; tot += bl[i]; bi[i] = tot; }
        const float incl = scan_add(tot, lane), base = incl - tot;
        float th[4]; float lmax = -3.0e38f;
#pragma unroll
        for (int i = 0; i < 4; ++i) { th[i] = gg[i] - (base + bi[i]); lmax = fmaxf(lmax, th[i]); }
        const float imax = scan_max(lmax, lane); float ex = __shfl_up(imax, 1); if (lane == 0) ex = 0.f; float m = fmaxf(ex, 0.f);
#pragma unroll
        for (int i = 0; i < 4; ++i) { const int c = 4 * lane + i; TH[c] = th[i]; MM[c] = m; if ((F.vcu & 31) == 0) MAp[c] = (base + bi[i] - bl[i]) + m; m = fmaxf(m, th[i]); }
        if (lane == 63) MM[256] = m;
    }
    __syncthreads();
    const int j = tid >> 5, el = tid & 31;
    float x[5][16]; float* ptr[5];
#pragma unroll
    for (int g = 0; g < 5; ++g) { const int eo = g * 32 + el; const bool valid = eo < 130; const int e = e0 + (valid ? eo : 0);
        ptr[g] = (e < 4096) ? (float*)(F.ws + WS_MST) + ((size_t)bh * NMCH + 16 * j) * 4096 + e : (float*)(F.ws + WS_MSN) + ((size_t)bh * NMCH + 16 * j) * 64 + (e - 4096);
        const size_t stride = (e < 4096) ? 4096 : 64;
#pragma unroll
        for (int i = 0; i < 16; ++i) x[g][i] = ptr[g][(size_t)i * stride]; }
    if (tid < 256) { const int c = tid; const float m1 = MM[c + 1]; WA[c] = fexp(MM[c] - m1); WB[c] = fexp(TH[c] - m1); WT[c] = fexp(TH[c] - MM[(c | 15) + 1]); }
    else if (tid < 271) { const int jj = tid - 256; MM[257 + jj] = fexp(MM[16 * jj] - MM[16 * jj + 16]); }
    __syncthreads();
#pragma unroll
    for (int g = 0; g < 5; ++g) {
        float T = 0.f;
#pragma unroll
        for (int i = 0; i < 16; ++i) T += WT[16 * j + i] * x[g][i];
        TT[(g * 16 + j) * 32 + el] = T; }
    __syncthreads();
#pragma unroll
    for (int g = 0; g < 5; ++g) { const int eo = g * 32 + el; const bool valid = eo < 130; const int e = e0 + (valid ? eo : 0); const size_t stride = (e < 4096) ? 4096 : 64;
        float st = 0.f;
        for (int jj = 0; jj < j; ++jj) st = MM[257 + jj] * st + TT[(g * 16 + jj) * 32 + el];
        if (valid) {
#pragma unroll
            for (int i = 0; i < 16; ++i) { const int c = 16 * j + i; ptr[g][(size_t)i * stride] = st; st = WA[c] * st + WB[c] * x[g][i]; } }
    }
    __syncthreads();
}
constexpr int M3_HB = 28672;
DI void m3_item(Frame& F, int l, int b, int cm) {
    PHASE_IDS;
    bf16* PROJ = (bf16*)(F.ws + WS_PROJ); const float* IFB = (const float*)(F.ws + WS_IF);
    const float* MARR = (const float*)(F.ws + WS_MSC) + 4096; const float* MST = (const float*)(F.ws + WS_MST); const float* MSN = (const float*)(F.ws + WS_MSN);
    LAS unsigned char* lds = F.lds;
    const int hd = F.wave >> 1, sub = F.wave & 1, r = lane & 31, hh = lane >> 5;
    const int c8i = tid & 31, cc = c8i * 8, head = c8i >> 3, d0 = (c8i & 7) * 8, s0 = tid >> 5; LAS unsigned char* hbs = lds + head * M3_HB;
    v4u xq[4][4], xk2[4][4], xv[4];
#pragma unroll
    for (int i = 0; i < 4; ++i) { const int pos = cm * MCH + s0 + 16 * i; load_taps(PROJ, b, pos, C_MQ + cc, xq[i]); load_taps(PROJ, b, pos, C_MK + cc, xk2[i]); xv[i] = *(const v4u*)(PROJ + (size_t)(b * SEQ + pos) * NP + C_MV + cc); }
    float ip = 0.f, lf = 0.f; const float mprev0 = MARR[(b * 4 + hd) * NMCH + cm];
    if (sub == 0) { const size_t row = (size_t)b * SEQ + cm * MCH + lane; ip = IFB[row * 8 + hd]; lf = IFB[row * 8 + 4 + hd]; }
    v4u gq[4];
#pragma unroll
    for (int i = 0; i < 4; ++i) gq[i] = *(const v4u*)(PROJ + (size_t)(b * SEQ + cm * MCH + s0 + 16 * i) * NP + C_MO + cc);
    __syncthreads();
    if (sub == 0) {
        const float bs = scan_add(lf, lane), es = ip - bs, em = scan_max(es, lane), mh = fmaxf(em, mprev0);
        LAS float* t = (LAS float*)(lds + hd * M3_HB + 27648); t[lane] = es; t[64 + lane] = mh; t[128 + lane] = bs;
    }
#pragma unroll
    for (int i = 0; i < 4; ++i) { float qv[8]; conv8_regs(xq[i], inp(F, I_CMW) + l * 2048 + cc, 1.f, qv); *(LAS v4u*)(hbs + (s0 + 16 * i) * 144 + d0 * 2) = pack8(qv); *(LAS v4u*)(hbs + 18432 + (s0 + 16 * i) * 144 + d0 * 2) = xv[i]; }
#pragma unroll
    for (int i = 0; i < 4; ++i) { float kv[8]; conv8_regs(xk2[i], inp(F, I_CMW) + l * 2048 + 256 + cc, 0.125f, kv); *(LAS v4u*)(hbs + 9216 + (s0 + 16 * i) * 144 + d0 * 2) = pack8(kv); }
    f32x4 cfr[2][4][2], nfr[8];
    { const float* Cst = MST + ((size_t)(b * 4 + hd) * NMCH + cm) * 4096; const float* nst = MSN + ((size_t)(b * 4 + hd) * NMCH + cm) * 64 + 32 * hh;
#pragma unroll
      for (int vt = 0; vt < 2; ++vt)
#pragma unroll
        for (int ks = 0; ks < 4; ++ks) { cfr[vt][ks][0] = *(const f32x4*)(Cst + (size_t)(vt * 32 + r) * 64 + 16 * ks + 8 * hh); cfr[vt][ks][1] = *(const f32x4*)(Cst + (size_t)(vt * 32 + r) * 64 + 16 * ks + 8 * hh + 4); }
#pragma unroll
      for (int q = 0; q < 8; ++q) nfr[q] = *(const f32x4*)(nst + 4 * q); }
    __syncthreads();
    f32x16 outv[2];
    {
        LAS unsigned char* hb = lds + hd * M3_HB; const LAS float* tb = (const LAS float*)(hb + 27648);
        const int tw = sub, t = tw * 32 + r; const int bh = b * 4 + hd;
        bf16x8 qf[4];
#pragma unroll
        for (int ks = 0; ks < 4; ++ks) qf[ks] = *(const LAS bf16x8*)(hb + (tw * 32 + r) * 144 + (16 * ks + 8 * hh) * 2);
        const float mh = tb[64 + t], bt = tb[128 + t], mprev = mprev0, decay = fexp(mprev - mh);
        f32x16 accN[2], accI[2];
#pragma unroll
        for (int i = 0; i < 16; ++i) { accN[0][i] = 0.f; accN[1][i] = 0.f; accI[0][i] = 0.f; accI[1][i] = 0.f; }
        float dsum = 0.f;
        for (int st = 0; st <= tw; ++st) {
            f32x16 sacc;
#pragma unroll
            for (int i = 0; i < 16; ++i) sacc[i] = 0.f;
#pragma unroll
            for (int ks = 0; ks < 4; ++ks) { const bf16x8 kf = *(const LAS bf16x8*)(hb + 9216 + (st * 32 + r) * 144 + (16 * ks + 8 * hh) * 2); sacc = MFMA32(kf, qf[ks], sacc); }
            float p[16];
#pragma unroll
            for (int reg = 0; reg < 16; ++reg) { const int s = st * 32 + crow(reg, hh); const float ev = fexp(tb[s] - mh) * sacc[reg]; p[reg] = (s <= t) ? ev : 0.f; dsum += p[reg]; }
#pragma unroll
            for (int k2 = 0; k2 < 2; ++k2) { v4u pw; pw.x = cvtpk(p[8 * k2], p[8 * k2 + 1]); pw.y = cvtpk(p[8 * k2 + 2], p[8 * k2 + 3]); pw.z = cvtpk(p[8 * k2 + 4], p[8 * k2 + 5]); pw.w = cvtpk(p[8 * k2 + 6], p[8 * k2 + 7]);
                const bf16x8 bfg = __builtin_bit_cast(bf16x8, pw);
#pragma unroll
                for (int vt = 0; vt < 2; ++vt) { bf16x8 av; GATHER8(av, hb + 18432, 144, vt * 32 + r, (st * 32 + 16 * k2 + 8 * (j >> 2) + 4 * hh + (j & 3)));
                    accN[vt] = MFMA32(av, bfg, accN[vt]); } }
        }
#pragma unroll
        for (int vt = 0; vt < 2; ++vt)
#pragma unroll
            for (int ks = 0; ks < 4; ++ks) { const f32x4 c0 = cfr[vt][ks][0], c1 = cfr[vt][ks][1];
                v4u cw; cw.x = cvtpk(c0.x, c0.y); cw.y = cvtpk(c0.z, c0.w); cw.z = cvtpk(c1.x, c1.y); cw.w = cvtpk(c1.z, c1.w);
                accI[vt] = MFMA32(__builtin_bit_cast(bf16x8, cw), qf[ks], accI[vt]); }
        float nq = 0.f;
#pragma unroll
        for (int q = 0; q < 4; ++q) { float x[8]; unpack8(*(const LAS v4u*)(hb + t * 144 + (32 * hh + 8 * q) * 2), x);
            nq += (x[0] * nfr[2 * q].x + x[1] * nfr[2 * q].y) + (x[2] * nfr[2 * q].z + x[3] * nfr[2 * q].w) + (x[4] * nfr[2 * q + 1].x + x[5] * nfr[2 * q + 1].y) + (x[6] * nfr[2 * q + 1].z + x[7] * nfr[2 * q + 1].w); }
        nq += __shfl_xor(nq, 32); dsum += __shfl_xor(dsum, 32);
        const float den = dsum + decay * nq, inv = frcp(fmaxf(fabsf(den), fexp(-(bt + mh))));
#pragma unroll
        for (int vt = 0; vt < 2; ++vt)
#pragma unroll
            for (int reg = 0; reg < 16; ++reg) outv[vt][reg] = (accN[vt][reg] + decay * accI[vt][reg]) * inv;
    }
    __syncthreads();
    {
        LAS unsigned char* hb = lds + hd * M3_HB; const int t = sub * 32 + r;
#pragma unroll
        for (int vt = 0; vt < 2; ++vt)
#pragma unroll
            for (int g4 = 0; g4 < 4; ++g4) { v2u w; w.x = cvtpk(outv[vt][4 * g4], outv[vt][4 * g4 + 1]); w.y = cvtpk(outv[vt][4 * g4 + 2], outv[vt][4 * g4 + 3]);
                *(LAS v2u*)(hb + t * 144 + (vt * 32 + 8 * g4 + 4 * hh) * 2) = w; }
    }
    __syncthreads();
    {
#pragma unroll
        for (int i = 0; i < 4; ++i) { const int s = s0 + 16 * i; float hv[8], gv[8];
            unpack8(*(const LAS v4u*)(lds + head * M3_HB + s * 144 + d0 * 2), hv);
            bf16* gp = PROJ + (size_t)(b * SEQ + cm * MCH + s) * NP + C_MO + cc; unpack8(gq[i], gv);
#pragma unroll
            for (int e = 0; e < 8; ++e) hv[e] *= sigm(gv[e]);
            *(v4u*)gp = pack8(hv); }
    }
}

constexpr int ATT_WB = 5120;
DI void att_item(Frame& F, int it) {
    PHASE_IDS;
    bf16* PROJ = (bf16*)(F.ws + WS_PROJ);
    const int qb = it & 511, h = (it >> 9) & 3, b = it >> 11, r = lane & 31, hh = lane >> 5;
    LAS unsigned char* wl = F.lds + F.wave * ATT_WB;
    const size_t rowbase = (size_t)b * SEQ; const int Q0 = qb * 32, qpos = Q0 + r;
    bf16x8 qf[4];
#pragma unroll
    for (int ks = 0; ks < 4; ++ks) qf[ks] = *(const bf16x8*)(PROJ + (rowbase + Q0 + r) * NP + C_SQ + h * 64 + 16 * ks + 8 * hh);
    f32x16 oacc[2];
#pragma unroll
    for (int i = 0; i < 16; ++i) { oacc[0][i] = 0.f; oacc[1][i] = 0.f; }
    float carry = 0.f;
    bf16x8 kfn[4]; v4u vrn[4];
#define ATT_LOAD(KT) do { const int k0_ = (KT) * 32; _Pragma("unroll") for (int ks = 0; ks < 4; ++ks) kfn[ks] = *(const bf16x8*)(PROJ + (rowbase + k0_ + tau(r)) * NP + C_SK + h * 64 + 16 * ks + 8 * hh); \
        _Pragma("unroll") for (int i = 0; i < 4; ++i) vrn[i] = *(const v4u*)(PROJ + (rowbase + k0_ + r) * NP + C_SV + h * 64 + (hh + 2 * i) * 8); } while (0)
    ATT_LOAD(qb);
    for (int kt = qb; kt >= 0; --kt) {
        const int key0 = kt * 32;
        bf16x8 kf[4]; v4u vraw[4];
#pragma unroll
        for (int i = 0; i < 4; ++i) { kf[i] = kfn[i]; vraw[i] = vrn[i]; }
        if (kt > 0) ATT_LOAD(kt - 1);
        f32x16 sacc;
#pragma unroll
        for (int i = 0; i < 16; ++i) sacc[i] = 0.f;
#pragma unroll
        for (int ks = 0; ks < 4; ++ks) sacc = MFMA32(kf[ks], qf[ks], sacc);
#pragma unroll
        for (int i = 0; i < 4; ++i) { const int key = r, d8 = (hh + 2 * i) * 8; const unsigned w[4] = {vraw[i].x, vraw[i].y, vraw[i].z, vraw[i].w};
#pragma unroll
            for (int e = 0; e < 4; ++e) { *(LAS unsigned short*)(wl + (d8 + 2 * e) * 80 + key * 2) = (unsigned short)(w[e] & 0xffffu); *(LAS unsigned short*)(wl + (d8 + 2 * e + 1) * 80 + key * 2) = (unsigned short)(w[e] >> 16); } }
        float z[16], lk[16]; const bool diag = (kt == qb);
#pragma unroll
        for (int reg = 0; reg < 16; ++reg) { z[reg] = sacc[reg] * 0.125f; const bool valid = !diag || (key0 + 16 * hh + reg < qpos); lk[reg] = valid ? -softplus(z[reg]) : 0.f; }
        float run = 0.f, suf[16];
#pragma unroll
        for (int reg = 15; reg >= 0; --reg) { run += lk[reg]; suf[reg] = run; }
        const float tot_o = __shfl_xor(run, 32), basev = carry + (hh == 0 ? tot_o : 0.f);
        float pa[16];
#pragma unroll
        for (int reg = 0; reg < 16; ++reg) { const bool valid = !diag || (key0 + 16 * hh + reg < qpos); pa[reg] = valid ? fexp(z[reg] + basev + suf[reg]) : 0.f; }
        carry += run + tot_o;
        asm volatile("s_waitcnt lgkmcnt(0)" ::: "memory");
#pragma unroll
        for (int k2 = 0; k2 < 2; ++k2) { v4u pw; pw.x = cvtpk(pa[8 * k2], pa[8 * k2 + 1]); pw.y = cvtpk(pa[8 * k2 + 2], pa[8 * k2 + 3]); pw.z = cvtpk(pa[8 * k2 + 4], pa[8 * k2 + 5]); pw.w = cvtpk(pa[8 * k2 + 6], pa[8 * k2 + 7]);
            const bf16x8 bfg = __builtin_bit_cast(bf16x8, pw);
#pragma unroll
            for (int dt = 0; dt < 2; ++dt) { const bf16x8 af = *(const LAS bf16x8*)(wl + (dt * 32 + r) * 80 + (16 * hh + 8 * k2) * 2); oacc[dt] = MFMA32(af, bfg, oacc[dt]); } }
        asm volatile("s_waitcnt lgkmcnt(0)" ::: "memory");
        if (__all(carry < -88.f)) break;
    }
#pragma unroll
    for (int dt = 0; dt < 2; ++dt)
#pragma unroll
        for (int g4 = 0; g4 < 4; ++g4) { v2u w; w.x = cvtpk(oacc[dt][4 * g4], oacc[dt][4 * g4 + 1]); w.y = cvtpk(oacc[dt][4 * g4 + 2], oacc[dt][4 * g4 + 3]);
            *(LAS v2u*)(wl + r * 144 + (dt * 32 + 8 * g4 + 4 * hh) * 2) = w; }
    asm volatile("s_waitcnt lgkmcnt(0)" ::: "memory");
#pragma unroll
    for (int i = 0; i < 4; ++i) { const int id = lane + 64 * i, row = id >> 3, c8 = id & 7;
        *(v4u*)(PROJ + (rowbase + Q0 + row) * NP + C_SQ + h * 64 + c8 * 8) = *(const LAS v4u*)(wl + row * 144 + c8 * 16); }
    asm volatile("s_waitcnt lgkmcnt(0)" ::: "memory");
}

DI int OPQ_BX() { int bx = blockIdx.x; asm volatile("" : "+s"(bx)); return bx; }
struct Args { const float* in[20]; float* out; unsigned char* ws; };
constexpr int CW_BAR = 4096, CW_FIN = 10240;
__global__ void __launch_bounds__(NWAVES * 64, 2) trunk_fwd(Args args) {
    extern __shared__ __attribute__((aligned(16))) unsigned char lds_raw[];
    Frame F;
    F.lds = (LAS unsigned char*)lds_raw;
    F.tid0 = threadIdx.x; F.wave = __builtin_amdgcn_readfirstlane(F.tid0 >> 6);
    F.G = gridDim.x; { const int bx = blockIdx.x; F.vcu = (F.G % 8 == 0) ? (bx % 8) * (F.G / 8) + bx / 8 : bx; }
    F.out = args.out; F.ws = args.ws;
    volatile LAS unsigned* MISC = (volatile LAS unsigned*)(F.lds + MISC_OFF);
    for (int u = F.tid0; u < (LDS_BYTES - LDSCTL_OFF) / 4; u += NWAVES * 64) ((LAS unsigned*)(F.lds + LDSCTL_OFF))[u] = 0u;
    __syncthreads();
    if (F.tid0 < 20) *(LAS unsigned long long*)(F.lds + PTR_OFF + 8 * F.tid0) = (unsigned long long)args.in[F.tid0];
    __syncthreads();
    XcdBarrier bar = xcd_barrier_post((unsigned*)(F.ws + WS_CTL) + CW_BAR, MISC + 8);
#define GRID_BAR() xcd_barrier(bar)
    bf16* XN = (bf16*)(F.ws + WS_XN); bf16* PROJ = (bf16*)(F.ws + WS_PROJ); bf16* XR2 = (bf16*)(F.ws + WS_GATES + 32 * MiB);
    const int gw = F.vcu * NWAVES + F.wave, NGW = F.G * NWAVES;

    bf16* XR = (bf16*)F.out;
    phase_weights(F, 0); phase_weights(F, 1);
    __syncthreads();
    phase_w8(F);
    phase_x0(F, inp(F, I_X));
    GRID_BAR();
    for (int l = 0; l < DEPTH; ++l) {
        float* SSQ = (float*)(F.ws + WS_SSQ); unsigned char* wl = F.ws + WS_WL0 + (size_t)l * WS_WLSTRIDE;
        { pg8::Gemm g{XR, (const bf16*)(wl + WO_WIN), M, 2560, D, D, D}; pg8::StaticOrder S; S.init(M, 2560, F.G, OPQ_BX());
          pg8::EpiProj E{PROJ, SSQ  , (float*)(F.ws + WS_IF), (const float*)(inp(F, I_IGB) + l * 4), (const float*)(inp(F, I_FGB) + l * 4)};
          pg8::gemm_phase<pg8::EpiProj, pg8::StaticOrder, pg8::AMapLinear, true, true>(F.lds, g, S, E, pg8::AMapLinear{}); }
        { pg8::Gemm g{(const bf16*)(F.ws + WS_A8), (const bf16*)(F.ws + WS_W8 + (size_t)l * 4 * MiB), M, 3072, 512, 512, 512}; pg8::StaticOrder S; S.init(M, 3072, F.G, OPQ_BX());
          pg8::EpiGates E{(bf16*)(F.ws + WS_GATES), SSQ, (const float*)(F.ws + WS_QSINV), (const float*)(F.ws + WS_W8 + (size_t)l * 4 * MiB + 3 * MiB)};
          pg8::gemm_phase<pg8::EpiGates, pg8::StaticOrder, pg8::AMapLinear, true, true, true>(F.lds, g, S, E, pg8::AMapLinear{}); }
        GRID_BAR();
        if (F.G == BATCH * NLCH) lru_item_sp(F, l, F.vcu / NLCH, F.vcu % NLCH);
        else for (int it = F.vcu; it < BATCH * NLCH; it += F.G) lru_item<false>(F, l, it / NLCH, it % NLCH);
        for (int it = F.vcu; it < BATCH * NMCH; it += F.G) m1_item(F, l, it / NMCH, it % NMCH);
        __syncthreads();
        for (int it = gw; it < BATCH * 4 * (SEQ / 32); it += NGW) att_item(F, it);
        GRID_BAR();
        m2_scan(F);
        if (F.G != BATCH * NLCH) for (int it = F.vcu; it < BATCH * NLCH; it += F.G) lru_item<true>(F, l, it / NLCH, it % NLCH);
        GRID_BAR();
        for (int it = F.vcu; it < BATCH * NMCH; it += F.G) m3_item(F, l, it / NMCH, it % NMCH);
        GRID_BAR();
        { pg8::Gemm g{PROJ, (const bf16*)(wl + WO_WOUT), M, D, 768, NP, 768}; pg8::StaticOrder S; S.init(M, D, F.G, OPQ_BX()); pg8::EpiMerge E{(const bf16*)(F.ws + WS_GATES), XN};
          pg8::gemm_phase<pg8::EpiMerge, pg8::StaticOrder, pg8::AMap3, true, true>(F.lds, g, S, E, pg8::AMap3{}); }
        GRID_BAR();
        { pg8::Gemm g{XN, (const bf16*)(wl + WO_WO), M, D, D, D, D}; pg8::StaticOrder S; S.init(M, D, F.G, OPQ_BX());
          pg8::EpiRes<true> E{(const float*)nullptr, XR, (l + 1 < DEPTH) ? XR : XR2  , SSQ + (size_t)M * 16  , (signed char*)(F.ws + WS_A8), (float*)(F.ws + WS_QSINV), SSQ  };
          pg8::gemm_phase<pg8::EpiRes<true>, pg8::StaticOrder, pg8::AMapLinear, true, true>(F.lds, g, S, E, pg8::AMapLinear{}); }
        GRID_BAR();
        { pg8::Gemm g{(const bf16*)(F.ws + WS_A8), (const bf16*)(wl + WO_W8F), M, 2 * FF, 512, 512, 512}; pg8::StaticOrder S; S.init(M, 2 * FF, F.G, OPQ_BX());
          pg8::EpiSwiglu E{PROJ, SSQ + (size_t)M * 16, (const float*)(F.ws + WS_QSINV), (const float*)(wl + WO_CSF)};
          pg8::gemm_phase<pg8::EpiSwiglu, pg8::StaticOrder, pg8::AMapLinear, true, true, true>(F.lds, g, S, E, pg8::AMapLinear{}); }
        GRID_BAR();
        if (l + 1 < DEPTH) {
          { pg8::Gemm g{PROJ, (const bf16*)(wl + WO_WF2), M, D, FF, FF, FF}; pg8::StaticOrder S; S.init(M, D, F.G, OPQ_BX());
            pg8::EpiRes<true> E{(const float*)nullptr, XR, XR, SSQ  , (signed char*)(F.ws + WS_A8), (float*)(F.ws + WS_QSINV), SSQ + (size_t)M * 16  };
            pg8::gemm_phase<pg8::EpiRes<true>, pg8::StaticOrder, pg8::AMapLinear, true, true>(F.lds, g, S, E, pg8::AMapLinear{}); }
          GRID_BAR();
        } else if (F.G == 256) {
          { pg8::Gemm g{PROJ, (const bf16*)(wl + WO_WF2), M, D, FF, FF, FF}; pg8::StaticOrder S; S.init(M, D, F.G, OPQ_BX());
            pg8::EpiFinal E{XR2, F.out, SSQ, (unsigned*)(F.ws + WS_CTL) + CW_FIN, (const float*)inp(F, I_FNG)};
            pg8::gemm_phase<pg8::EpiFinal, pg8::StaticOrder, pg8::AMapLinear, true, true>(F.lds, g, S, E, pg8::AMapLinear{}); }
        } else {
          { pg8::Gemm g{PROJ, (const bf16*)(wl + WO_WF2), M, D, FF, FF, FF}; pg8::StaticOrder S; S.init(M, D, F.G, OPQ_BX());
            pg8::EpiRes<true> E{(const float*)nullptr, XR2, XN, SSQ, (signed char*)nullptr, (float*)(F.ws + WS_QSINV), SSQ + (size_t)M * 16};
            pg8::gemm_phase<pg8::EpiRes<true>, pg8::StaticOrder, pg8::AMapLinear, true, true>(F.lds, g, S, E, pg8::AMapLinear{}); }
          GRID_BAR();
          phase_final_norm(F, F.out, inp(F, I_FNG));
        }
    }
}

extern "C" void kernel_launch(void* const* d_in, const int* in_sizes, int n_in, void* d_out, int out_size, void* d_ws, size_t ws_size, hipStream_t stream) {
    static int grid = 0;
    if (grid == 0) {
        if (n_in != 20 || in_sizes[0] != M * D || out_size != M * D || ws_size < WS_END) { fprintf(stderr, "kernel_launch: unexpected shapes (n_in %d, in0 %d, out %d, ws %zu)\n", n_in, n_in > 0 ? in_sizes[0] : -1, out_size, ws_size); grid = -1; return; }
        int dev = 0, cus = 0, per_cu = 0;
        if (hipGetDevice(&dev) != hipSuccess || hipDeviceGetAttribute(&cus, hipDeviceAttributeMultiprocessorCount, dev) != hipSuccess) { grid = -1; return; }
        if (hipFuncSetAttribute((const void*)trunk_fwd, hipFuncAttributeMaxDynamicSharedMemorySize, LDS_BYTES) != hipSuccess) { fprintf(stderr, "kernel_launch: hipFuncSetAttribute failed\n"); grid = -1; return; }
        if (hipOccupancyMaxActiveBlocksPerMultiprocessor(&per_cu, (const void*)trunk_fwd, NWAVES * 64, LDS_BYTES) != hipSuccess || per_cu < 1)
            fprintf(stderr, "kernel_launch: note: occupancy query reports %d workgroups per CU\n", per_cu);
        (void)hipGetLastError();
        if (cus != 256) { fprintf(stderr, "kernel_launch: built for a 256-CU device (got %d)\n", cus); grid = -1; return; }
        grid = cus;
    }
    if (grid < 0) return;
    if (hipMemsetAsync((char*)d_ws + WS_CTL, 0, CTL_ZERO_BYTES, stream) != hipSuccess) return;
    Args a{};
    for (int i = 0; i < 20; ++i) a.in[i] = (const float*)d_in[i];
    a.out = (float*)d_out; a.ws = (unsigned char*)d_ws;
    hipLaunchKernelGGL(trunk_fwd, dim3(grid), dim3(NWAVES * 64), LDS_BYTES, stream, a);
}
```

```cpp
#include <hip/hip_runtime.h>
#include <cstdio>
#include <cstdint>

#define DI __device__ __forceinline__
#define GAS __attribute__((address_space(1)))
#define LAS __attribute__((address_space(3)))
typedef unsigned short bf16;
typedef unsigned v4u __attribute__((ext_vector_type(4)));
typedef unsigned v2u __attribute__((ext_vector_type(2)));
typedef float f32x2 __attribute__((ext_vector_type(2)));
typedef float f32x4 __attribute__((ext_vector_type(4)));
typedef float f32x16 __attribute__((ext_vector_type(16)));
typedef short bf16x8 __attribute__((ext_vector_type(8)));
typedef short s16x4 __attribute__((ext_vector_type(4)));
typedef __bf16 bf16x2_t __attribute__((ext_vector_type(2)));

constexpr int BATCH = 2, SEQ = 16384, D = 1024, M = BATCH * SEQ, DEPTH = 2;
constexpr int FF = 2816;
constexpr int NP = 2304;
constexpr int C_LX = 0, C_LG = 256, C_MQ = 512, C_MK = 768, C_MV = 1024, C_MO = 1280, C_SQ = 1536, C_SK = 1792, C_SV = 2048, C_GA = 2304;
constexpr int IN_COLS = 5384;
constexpr float EPS = 1e-6f;
constexpr int LCH = 128, NLCH = SEQ / LCH;
constexpr int MCH = 64, NMCH = SEQ / MCH;

constexpr size_t MiB = 1u << 20;
constexpr size_t WS_CTL = 0, CTL_ZERO_BYTES = 64 * 1024;
constexpr size_t WS_SSQ = 503 * MiB;
constexpr size_t WS_WL0 = 2 * MiB, WS_WLSTRIDE = 33 * MiB;
constexpr size_t WO_WIN = 0;
constexpr size_t WO_WOUT = 11 * MiB;
constexpr size_t WO_WO = 13 * MiB;
constexpr size_t WO_WF1 = 15 * MiB;
constexpr size_t WO_WF2 = 26 * MiB;
constexpr size_t WO_LRUW = 32 * MiB;
constexpr size_t WS_LSUM = 68 * MiB;
constexpr size_t WS_MSC = 68 * MiB + 512 * 1024;
constexpr size_t WS_IF = 69 * MiB;
constexpr size_t WS_MST = 70 * MiB;
constexpr size_t WS_MSN = 102 * MiB;
constexpr size_t WS_XN = 103 * MiB;
constexpr size_t WS_PROJ = 167 * MiB;
constexpr size_t WS_GATES = WS_PROJ + 144 * MiB;
constexpr size_t WO_W8F = WO_WF1, WO_CSF = WO_WF1 + 6 * MiB;
constexpr float QCLIP = 127.f / 4.5f;
constexpr size_t WS_A8 = WS_PROJ + 248 * MiB;
constexpr size_t WS_W8 = WS_PROJ + 284 * MiB;
constexpr size_t WS_QSINV = WS_PROJ + 296 * MiB;
constexpr size_t WS_END = 507 * MiB;

constexpr int RING_BYTES = 131072;
constexpr int LDS_BYTES = 147456;
constexpr int LDSCTL_OFF = LDS_BYTES - 512, MISC_OFF = LDSCTL_OFF + 320;
constexpr int CFTAB_OFF = 131072;
constexpr int RSTAB_OFF = 135680;
static_assert(RSTAB_OFF >= RING_BYTES && RSTAB_OFF + 11 * 1024 <= LDSCTL_OFF, "LDS map");

DI unsigned cvtpk(float lo, float hi) { f32x2 v = {lo, hi}; bf16x2_t b = __builtin_convertvector(v, bf16x2_t); return __builtin_bit_cast(unsigned, b); }
DI float bf2f(unsigned short b) { return __uint_as_float(((unsigned)b) << 16); }
DI float bflo(unsigned w) { return __uint_as_float(w << 16); }
DI float bfhi(unsigned w) { return __uint_as_float(w & 0xffff0000u); }
DI float fexp(float x) { return __expf(x); }
DI float frcp(float x) { return __builtin_amdgcn_rcpf(x); }
DI float sigm(float x) { return frcp(1.f + fexp(-x)); }
DI float softplus(float z) { return fmaxf(z, 0.f) + __logf(1.f + fexp(-fabsf(z))); }
DI float siluf(float x) { return x * sigm(x); }
DI float gelu_tanh(float x) { const float u = 0.7978845608028654f * (x + 0.044715f * x * x * x); const float t = 1.f - 2.f * frcp(fexp(2.f * u) + 1.f); return 0.5f * x * (1.f + t); }
#define MFMA32(a, b, c) __builtin_amdgcn_mfma_f32_32x32x16_bf16((a), (b), (c), 0, 0, 0)
DI int crow(int reg, int h) { return (reg & 3) + 8 * (reg >> 2) + 4 * h; }
DI int tau(int m) { return (((m >> 2) & 1) << 4) | ((m >> 3) << 2) | (m & 3); }

namespace pg8 {
#define PG8_LAS __attribute__((address_space(3)))
typedef unsigned short bf16_t;
typedef unsigned u32x4 __attribute__((ext_vector_type(4)));
typedef int i32x4 __attribute__((ext_vector_type(4)));
typedef unsigned u32x2 __attribute__((ext_vector_type(2)));
constexpr int BM = 256, BK = 64, HALF = 128, HTB = HALF * BK * 2, STAGE_BYTES = 8 * HTB, NXCD = 8, WGM = 8;
__host__ __device__ __forceinline__ int lds_byte(int r, int c) { const int st = (r >> 4) * 2 + (c >> 5), rr = r & 15, cc = c & 31, ob = rr * 64 + cc * 2; return st * 1024 + (ob ^ (((ob >> 9) & 1) << 5)); }
__host__ __device__ __forceinline__ void stage_rc(int b, int& R, int& C) { const int st = b / 1024, sb = b % 1024, swz = sb ^ (((sb >> 9) & 1) << 5); R = (st >> 1) * 16 + swz / 64; C = (st & 1) * 32 + (swz % 64) / 2; }
__host__ __device__ __forceinline__ int perm32(int rho) { const int n = rho >> 4, i = rho & 15; return 8 * (i >> 2) + 4 * n + (i & 3); }

struct Unit { int pm, pn; };
struct Gemm { const bf16_t* A; const bf16_t* Bt; int M, N, K, lda, ldb; };
struct StaticOrder {
    int nM, nN, nwg, G, c;
    __host__ __device__ void init(int M_, int N_, int G_, int c_) { nM = M_ / BM; nN = N_ / BM; nwg = nM * nN; G = G_; c = c_; }
    __host__ __device__ bool next(int i, Unit& u) const {
        const long L = (long)i * G + c; if (L >= nwg) return false;
        int wgid = (int)L; { const int q = nwg / NXCD, r = nwg % NXCD, xcd = wgid % NXCD, off = wgid / NXCD; wgid = (xcd < r ? xcd * (q + 1) : r * (q + 1) + (xcd - r) * q) + off; }
        const int nig = WGM * nN, gid = wgid / nig, fm = gid * WGM, gsz = (nM - fm) < WGM ? (nM - fm) : WGM;
        u.pm = fm + ((wgid % nig) % gsz); u.pn = (wgid % nig) / gsz; return true;
    }
};
__device__ __forceinline__ float rstd_of(const float* slots) {
    const f32x4 a = *(const f32x4*)slots, b = *(const f32x4*)(slots + 4), c = *(const f32x4*)(slots + 8), d = *(const f32x4*)(slots + 12);
    const float s = ((a.x + a.y) + (a.z + a.w)) + ((b.x + b.y) + (b.z + b.w)) + (((c.x + c.y) + (c.z + c.w)) + ((d.x + d.y) + (d.z + d.w)));
    return 1.f / sqrtf(s * (1.f / D) + EPS); }
struct AMapLinear { __device__ __forceinline__ size_t operator()(int t) const { return (size_t)t * (BK * 2); } };
struct AMap3 { __device__ __forceinline__ size_t operator()(int t) const { const int s = t >> 2; return (size_t)((256 + 1024 * s - 768 * (s >> 1)) * 2 + (t & 3) * (BK * 2)); } };

template <class Epi, class Sched, class AMap, bool ALIGN_EPI = false, bool SP2 = false, bool I8 = false>
__device__ __forceinline__ void gemm_phase(PG8_LAS unsigned char* lds, const Gemm g, const Sched& S, const Epi& E, const AMap& AM) {
    int tid_ = threadIdx.x; asm volatile("" : "+v"(tid_));
    const int tid = tid_, wid = __builtin_amdgcn_readfirstlane(tid >> 6), lane = tid & 63, wr = wid >> 2, wc = wid & 3, fr = lane & 15, fq = lane >> 4;
    const int K = g.K, nt = K / BK;
    unsigned voffA[2], voffB[2];
#pragma unroll
    for (int i = 0; i < 2; ++i) { int R, C; stage_rc(tid * 16 + i * 8192, R, C); const int Rb = Epi::PERM ? ((R & ~31) + perm32(R & 31)) : R;
        voffA[i] = (unsigned)(R * g.lda + C) * 2u; voffB[i] = (unsigned)(Rb * g.ldb + C) * 2u; }
    const size_t kstep = (size_t)(BK * 2);
    const size_t hstepA = (size_t)HALF * g.lda * 2, hstepB = (size_t)HALF * g.ldb * 2;
    const size_t tstepA = 2 * hstepA, tstepB = 2 * hstepB;
    const unsigned ldsw = (unsigned)wid * 1024u;
    const int aoff = lds_byte(wr * 64 + fr, fq * 8), boff = lds_byte(wc * 32 + fr, fq * 8);
#define PG8_SA(b, h) (((b) * 2 + (h)) * HTB)
#define PG8_SB(b, h) ((4 + (b) * 2 + (h)) * HTB)
#define PG8_STAGE(bufoff, gbase, voff) do { _Pragma("unroll") for (int _i = 0; _i < 2; ++_i) \
        __builtin_amdgcn_global_load_lds((const unsigned*)((const char*)(gbase) + (voff)[_i]), (PG8_LAS unsigned*)(lds + (bufoff) + ldsw + _i * 8192), 16, 0, 0); } while (0)
#define PG8_LDA(dst, b, h) do { _Pragma("unroll") for (int m = 0; m < 4; ++m) _Pragma("unroll") for (int k = 0; k < 2; ++k) dst[m][k] = *(const PG8_LAS bf16x8*)(lds + PG8_SA(b, h) + aoff + m * 2048 + k * 1024); } while (0)
#define PG8_LDB(dst, b, h) do { _Pragma("unroll") for (int n = 0; n < 2; ++n) _Pragma("unroll") for (int k = 0; k < 2; ++k) dst[n][k] = *(const PG8_LAS bf16x8*)(lds + PG8_SB(b, h) + boff + n * 2048 + k * 1024); } while (0)
#define PG8_MMA(ai, bj, At, Bt) do { __builtin_amdgcn_s_setprio(1); _Pragma("unroll") for (int m = 0; m < 4; ++m) _Pragma("unroll") for (int n = 0; n < 2; ++n) _Pragma("unroll") for (int k = 0; k < 2; ++k) { \
        if constexpr (I8) acc[ai][bj][m][n] = __builtin_bit_cast(f32x4, __builtin_amdgcn_mfma_i32_16x16x64_i8(__builtin_bit_cast(i32x4, Bt[n][k]), __builtin_bit_cast(i32x4, At[m][k]), __builtin_bit_cast(i32x4, acc[ai][bj][m][n]), 0, 0, 0)); \
        else acc[ai][bj][m][n] = __builtin_amdgcn_mfma_f32_16x16x32_bf16(Bt[n][k], At[m][k], acc[ai][bj][m][n], 0, 0, 0); } __builtin_amdgcn_s_setprio(0); } while (0)
#define PG8_WAIT_V(n) asm volatile("s_waitcnt vmcnt(" #n ")" ::: "memory")
#define PG8_WAIT_L(n) asm volatile("s_waitcnt lgkmcnt(" #n ")" ::: "memory")
#define PG8_BAR __builtin_amdgcn_s_barrier()
#define PG8_SCHED __builtin_amdgcn_sched_barrier(0)
    Unit cur, nxt; int ui = 0, ts = 0;
    if (!S.next(0, cur)) return;
    f32x4 acc[2][2][4][2];
#pragma unroll
    for (int a = 0; a < 2; ++a)
#pragma unroll
        for (int b = 0; b < 2; ++b)
#pragma unroll
            for (int m = 0; m < 4; ++m)
#pragma unroll
                for (int n = 0; n < 2; ++n) acc[a][b][m][n] = (f32x4){0.f, 0.f, 0.f, 0.f};
    bf16x8 At[4][2], B0[2][2], B1[2][2];
    const char* cA = (const char*)g.A + (size_t)cur.pm * tstepA; const char* cB = (const char*)g.Bt + (size_t)cur.pn * tstepB;
    if constexpr (SP2) {
        PG8_STAGE(PG8_SB(0, 0), cB, voffB); PG8_STAGE(PG8_SB(0, 1), cB + hstepB, voffB); PG8_STAGE(PG8_SA(0, 0), cA + AM(0), voffA); PG8_STAGE(PG8_SA(0, 1), cA + AM(0) + hstepA, voffA);
        if constexpr (Epi::HAS_PREP) { int lastpm = -1, slot = -1; for (int i = 0; S.next(i, nxt); ++i) if (nxt.pm != lastpm) { lastpm = nxt.pm; ++slot; E.prep(lds, slot, nxt, tid); } asm volatile("s_waitcnt lgkmcnt(0)" ::: "memory"); }
        if (wr == 1) PG8_BAR;
        PG8_WAIT_V(2); PG8_BAR;
        PG8_STAGE(PG8_SB(1, 0), cB + kstep, voffB); PG8_STAGE(PG8_SA(1, 0), cA + AM(1), voffA); PG8_STAGE(PG8_SB(1, 1), cB + hstepB + kstep, voffB);
        PG8_WAIT_V(6); PG8_BAR;
    } else {
        if constexpr (Epi::HAS_PREP) { int lastpm = -1, slot = -1; for (int i = 0; S.next(i, nxt); ++i) if (nxt.pm != lastpm) { lastpm = nxt.pm; ++slot; E.prep(lds, slot, nxt, tid); } asm volatile("s_waitcnt lgkmcnt(0)" ::: "memory"); }
        PG8_STAGE(PG8_SB(0, 0), cB, voffB); PG8_STAGE(PG8_SA(0, 0), cA + AM(0), voffA); PG8_STAGE(PG8_SB(0, 1), cB + hstepB, voffB); PG8_STAGE(PG8_SA(0, 1), cA + AM(0) + hstepA, voffA);
        if (wr == 1) PG8_BAR;
        PG8_WAIT_V(4); PG8_BAR;
        PG8_STAGE(PG8_SB(1, 0), cB + kstep, voffB); PG8_STAGE(PG8_SA(1, 0), cA + AM(1), voffA); PG8_STAGE(PG8_SB(1, 1), cB + hstepB + kstep, voffB);
        PG8_WAIT_V(6); PG8_BAR;
    }
    for (;;) {
        const bool has_next = S.next(ui + 1, nxt);
        if constexpr (Epi::HAS_COLTAB) { if (wid < 4) __builtin_amdgcn_global_load_lds((const unsigned*)(E.cs + cur.pn * BM + tid), (PG8_LAS unsigned*)(lds + CFTAB_OFF + (ui & 1) * 1024 + wid * 256), 4, 0, 0); }
        const char* nA = has_next ? (const char*)g.A + (size_t)nxt.pm * tstepA : cA; const char* nB = has_next ? (const char*)g.Bt + (size_t)nxt.pn * tstepB : cB;
        for (int t = 0; t < nt; t += 2) {
            const bool last = (t == nt - 2);
            const char* a1 = cA + AM(t + 1);
            const char* a2 = last ? nA + AM(0) : cA + AM(t + 2); const char* b2 = last ? nB : cB + (size_t)(t + 2) * kstep;
            const char* a3 = last ? nA + AM(1) : cA + AM(t + 3); const char* b3 = b2 + kstep;
            if constexpr (SP2) {
            PG8_LDB(B0, 0, 0); PG8_LDB(B1, 0, 1); PG8_SCHED; PG8_LDA(At, 0, 0); PG8_STAGE(PG8_SA(1, 1), a1 + hstepA, voffA);
            PG8_WAIT_V(8); PG8_WAIT_L(0); PG8_BAR; PG8_MMA(0, 0, At, B0); PG8_MMA(0, 1, At, B1); PG8_BAR; PG8_SCHED;
            PG8_LDA(At, 0, 1); PG8_STAGE(PG8_SB(0, 0), b2, voffB); PG8_STAGE(PG8_SB(0, 1), b2 + hstepB, voffB); PG8_STAGE(PG8_SA(0, 0), a2, voffA);
            PG8_WAIT_V(8); PG8_WAIT_L(0); PG8_BAR; PG8_MMA(1, 0, At, B0); PG8_MMA(1, 1, At, B1); PG8_BAR; PG8_SCHED;
            PG8_LDB(B0, 1, 0); PG8_LDB(B1, 1, 1); PG8_SCHED; PG8_LDA(At, 1, 0); PG8_STAGE(PG8_SA(0, 1), a2 + hstepA, voffA);
            PG8_WAIT_V(8); PG8_WAIT_L(0); PG8_BAR; PG8_MMA(0, 0, At, B0); PG8_MMA(0, 1, At, B1); PG8_BAR; PG8_SCHED;
            PG8_LDA(At, 1, 1); PG8_STAGE(PG8_SB(1, 0), b3, voffB); PG8_STAGE(PG8_SB(1, 1), b3 + hstepB, voffB); PG8_STAGE(PG8_SA(1, 0), a3, voffA);
            PG8_WAIT_V(8); PG8_WAIT_L(0); PG8_BAR; PG8_MMA(1, 0, At, B0); PG8_MMA(1, 1, At, B1); PG8_BAR; PG8_SCHED;
            } else {
            PG8_LDB(B0, 0, 0); PG8_SCHED; PG8_LDA(At, 0, 0); PG8_STAGE(PG8_SA(1, 1), a1 + hstepA, voffA);
            PG8_WAIT_L(8); PG8_BAR; PG8_WAIT_L(0); PG8_MMA(0, 0, At, B0); PG8_BAR; PG8_SCHED;
            PG8_LDB(B1, 0, 1); PG8_STAGE(PG8_SB(0, 0), b2, voffB);
            PG8_BAR; PG8_WAIT_L(0); PG8_MMA(0, 1, At, B1); PG8_BAR;
            PG8_LDA(At, 0, 1); PG8_STAGE(PG8_SA(0, 0), a2, voffA);
            PG8_BAR; PG8_WAIT_L(0); PG8_MMA(1, 0, At, B0); PG8_BAR; PG8_SCHED;
            PG8_STAGE(PG8_SB(0, 1), b2 + hstepB, voffB);
            PG8_WAIT_V(6); PG8_BAR; PG8_MMA(1, 1, At, B1); PG8_BAR;
            PG8_LDB(B0, 1, 0); PG8_SCHED; PG8_LDA(At, 1, 0); PG8_STAGE(PG8_SA(0, 1), a2 + hstepA, voffA);
            PG8_WAIT_L(8); PG8_BAR; PG8_WAIT_L(0); PG8_MMA(0, 0, At, B0); PG8_BAR; PG8_SCHED;
            PG8_LDB(B1, 1, 1); PG8_STAGE(PG8_SB(1, 0), b3, voffB);
            PG8_BAR; PG8_WAIT_L(0); PG8_MMA(0, 1, At, B1); PG8_BAR;
            PG8_LDA(At, 1, 1); PG8_STAGE(PG8_SA(1, 0), a3, voffA);
            PG8_BAR; PG8_WAIT_L(0); PG8_MMA(1, 0, At, B0); PG8_BAR; PG8_SCHED;
            PG8_STAGE(PG8_SB(1, 1), b3 + hstepB, voffB);
            PG8_WAIT_V(6); PG8_BAR; PG8_MMA(1, 1, At, B1); PG8_BAR;
            }
            if constexpr (Epi::HAS_MID) { if (!last && ((t + 2) & 3) == 0) E.mid(acc, cur, (t + 2) >> 2, wr, wc, fr, fq); }
        }
        if constexpr (ALIGN_EPI) { if (wr == 0) PG8_BAR; }
        E(acc, cur, ui | (ts << 8), lds, wr, wc, fr, fq);
        if (!has_next) break;
#pragma unroll
        for (int a = 0; a < 2; ++a)
#pragma unroll
            for (int b = 0; b < 2; ++b)
#pragma unroll
                for (int m = 0; m < 4; ++m)
#pragma unroll
                    for (int n = 0; n < 2; ++n) acc[a][b][m][n] = (f32x4){0.f, 0.f, 0.f, 0.f};
        ts += (nxt.pm != cur.pm) ? 1 : 0; cur = nxt; cA = nA; cB = nB; ++ui;
        if constexpr (ALIGN_EPI) { if (wr == 1) PG8_BAR; }
    }
    PG8_WAIT_V(0);
    if constexpr (!ALIGN_EPI) { if (wr == 0) PG8_BAR; }
    PG8_BAR;
#undef PG8_SA
#undef PG8_SB
#undef PG8_STAGE
#undef PG8_LDA
#undef PG8_LDB
#undef PG8_MMA
#undef PG8_WAIT_V
#undef PG8_WAIT_L
#undef PG8_BAR
#undef PG8_SCHED
}

struct EpiProj {
    static constexpr bool PERM = true, HAS_MID = false, HAS_PREP = true, HAS_COLTAB = false;
    bf16_t* O; const float* ssq; float* IFB; const float* igb; const float* fgb;
    __device__ __forceinline__ void prep(PG8_LAS unsigned char* lds, int i, const Unit& u, int tid) const { if (tid < 256) *(PG8_LAS float*)(lds + RSTAB_OFF + (i * 256 + tid) * 4) = rstd_of(ssq + (size_t)(u.pm * BM + tid) * 16); }
    __device__ __forceinline__ void operator()(const f32x4 (&acc)[2][2][4][2], const Unit& u, int ui, PG8_LAS unsigned char* lds, int wr, int wc, int fr, int fq) const {
        const int row0 = u.pm * BM + wr * 64 + fr, col0 = u.pn * BM + wc * 32 + 8 * fq;
        float rs[2][4];
#pragma unroll
        for (int ai = 0; ai < 2; ++ai)
#pragma unroll
            for (int m = 0; m < 4; ++m) rs[ai][m] = *(const PG8_LAS float*)(lds + RSTAB_OFF + ((ui >> 8) * 256 + wr * 64 + fr + ai * HALF + m * 16) * 4);
        if (u.pn < 9) {
#pragma unroll
        for (int ai = 0; ai < 2; ++ai)
#pragma unroll
            for (int m = 0; m < 4; ++m) { bf16_t* rowp = O + (size_t)(row0 + ai * HALF + m * 16) * NP + col0; const float r = rs[ai][m];
#pragma unroll
                for (int bj = 0; bj < 2; ++bj) { const f32x4 v0 = acc[ai][bj][m][0] * r, v1 = acc[ai][bj][m][1] * r;
                    u32x4 w; w.x = cvtpk(v0[0], v0[1]); w.y = cvtpk(v0[2], v0[3]); w.z = cvtpk(v1[0], v1[1]); w.w = cvtpk(v1[2], v1[3]);
                    *(u32x4*)(rowp + bj * HALF) = w; } }
        } else if (wc == 0 && fq == 0) {
            const f32x4 bi = *(const f32x4*)igb, bf = *(const f32x4*)fgb;
#pragma unroll
            for (int ai = 0; ai < 2; ++ai)
#pragma unroll
                for (int m = 0; m < 4; ++m) { float* p = IFB + (size_t)(row0 + ai * HALF + m * 16) * 8; const float r = rs[ai][m];
                    const f32x4 vi = acc[ai][0][m][0] * r + bi; f32x4 vf = acc[ai][0][m][1] * r + bf;
#pragma unroll
                    for (int j = 0; j < 4; ++j) vf[j] = -softplus(-vf[j]);
                    *(f32x4*)p = vi; *(f32x4*)(p + 4) = vf; }
        }
    }
};
struct EpiGates {
    static constexpr bool PERM = true, HAS_MID = false, HAS_PREP = true, HAS_COLTAB = true;
    bf16_t* GT; const float* ssq; const float* qsinv; const float* cs;
    __device__ __forceinline__ void prep(PG8_LAS unsigned char* lds, int i, const Unit& u, int tid) const { if (tid < 256) { const size_t row = (size_t)(u.pm * BM + tid); *(PG8_LAS float*)(lds + RSTAB_OFF + (i * 256 + tid) * 4) = rstd_of(ssq + row * 16) * qsinv[row] * -1.4426950408889634f; } }
    __device__ __forceinline__ void operator()(const f32x4 (&acc)[2][2][4][2], const Unit& u, int ui, PG8_LAS unsigned char* lds, int wr, int wc, int fr, int fq) const {
        const int col0 = u.pn * BM + wc * 32 + 8 * fq;
        f32x4 cf[2][2];
#pragma unroll
        for (int bj = 0; bj < 2; ++bj)
#pragma unroll
            for (int n = 0; n < 2; ++n) cf[bj][n] = *(const PG8_LAS f32x4*)(lds + CFTAB_OFF + (ui & 1) * 1024 + (wc * 32 + 8 * fq + bj * HALF + 4 * n) * 4);
        u32x4* tp = (u32x4*)GT + ((size_t)(u.pm * 12 + u.pn) * 8) * 512 + ((wr * 4 + wc) * 64 + fq * 16 + fr);
#pragma unroll
        for (int ai = 0; ai < 2; ++ai)
#pragma unroll
            for (int m = 0; m < 4; ++m) { const float r = *(const PG8_LAS float*)(lds + RSTAB_OFF + ((ui >> 8) * 256 + wr * 64 + fr + ai * HALF + m * 16) * 4); unsigned q[4];
#pragma unroll
                for (int bj = 0; bj < 2; ++bj)
#pragma unroll
                    for (int n = 0; n < 2; ++n) { const i32x4 ia = __builtin_bit_cast(i32x4, acc[ai][bj][m][n]); const f32x4 cr = cf[bj][n] * r; unsigned w = 0u;
#define Q8(x) __builtin_amdgcn_rcpf(__builtin_fmaf(__builtin_amdgcn_exp2f(x), 1.f / 255.f, 1.f / 255.f))
                        w = __builtin_amdgcn_cvt_pk_u8_f32(Q8((float)ia[0] * cr[0]), 0, w); w = __builtin_amdgcn_cvt_pk_u8_f32(Q8((float)ia[1] * cr[1]), 1, w); w = __builtin_amdgcn_cvt_pk_u8_f32(Q8((float)ia[2] * cr[2]), 2, w); w = __builtin_amdgcn_cvt_pk_u8_f32(Q8((float)ia[3] * cr[3]), 3, w); q[bj * 2 + n] = w; }
#undef Q8
                u32x4 w4; w4.x = q[0]; w4.y = q[1]; w4.z = q[2]; w4.w = q[3];
                tp[(size_t)(ai * 4 + m) * 512] = w4; }
    }
};
struct EpiMerge {
    static constexpr bool PERM = true, HAS_MID = true, HAS_PREP = false, HAS_COLTAB = false;
    const bf16_t* GT; bf16_t* O;
    __device__ __forceinline__ static void ld8(const bf16_t* p, float (&g)[8]) { const u32x4 w = *(const u32x4*)p;
        g[0] = bflo(w.x); g[1] = bfhi(w.x); g[2] = bflo(w.y); g[3] = bfhi(w.y); g[4] = bflo(w.z); g[5] = bfhi(w.z); g[6] = bflo(w.w); g[7] = bfhi(w.w);
#pragma unroll
        for (int j = 0; j < 8; ++j) g[j] = fmaxf(g[j], 1e-20f); }
    __device__ __forceinline__ static void raw4(unsigned w, float (&g)[8], int o) {
        g[o + 0] = fmaxf((float)(w & 0xffu), 0.5f); g[o + 1] = fmaxf((float)((w >> 8) & 0xffu), 0.5f); g[o + 2] = fmaxf((float)((w >> 16) & 0xffu), 0.5f); g[o + 3] = fmaxf((float)(w >> 24), 0.5f); }
    __device__ __forceinline__ static void up4(unsigned w, float (&g)[8], int o) {
        g[o + 0] = fmaxf((float)(w & 0xffu), 0.5f) * (1.f / 255.f); g[o + 1] = fmaxf((float)((w >> 8) & 0xffu), 0.5f) * (1.f / 255.f);
        g[o + 2] = fmaxf((float)((w >> 16) & 0xffu), 0.5f) * (1.f / 255.f); g[o + 3] = fmaxf((float)(w >> 24), 0.5f) * (1.f / 255.f); }
    __device__ __forceinline__ void mid(f32x4 (&acc)[2][2][4][2], const Unit& u, int nb  , int wr, int wc, int fr, int fq) const {
        int lid = (wr * 4 + wc) * 64 + fq * 16 + fr;
        asm volatile("" : "+v"(lid));
        const u32x4* tp = (const u32x4*)GT + ((size_t)(u.pm * 12 + (nb - 1) * 4 + u.pn) * 8) * 512 + lid; const u32x4* tn = tp + (size_t)4 * 8 * 512;
        u32x4 wp[2][4], wn[2][4];
#pragma unroll
        for (int ai = 0; ai < 2; ++ai)
#pragma unroll
            for (int m = 0; m < 4; ++m) { const size_t o = (size_t)(ai * 4 + m) * 512; wp[ai][m] = tp[o]; wn[ai][m] = tn[o]; }
#pragma unroll
        for (int ai = 0; ai < 2; ++ai)
#pragma unroll
            for (int m = 0; m < 4; ++m) { float gp[8], gn[8];
                raw4(wp[ai][m].x, gp, 0); raw4(wp[ai][m].y, gp, 4); raw4(wn[ai][m].x, gn, 0); raw4(wn[ai][m].y, gn, 4);
#pragma unroll
                for (int j = 0; j < 4; ++j) { acc[ai][0][m][0][j] *= gp[j] * frcp(gn[j]); acc[ai][0][m][1][j] *= gp[4 + j] * frcp(gn[4 + j]); }
                raw4(wp[ai][m].z, gp, 0); raw4(wp[ai][m].w, gp, 4); raw4(wn[ai][m].z, gn, 0); raw4(wn[ai][m].w, gn, 4);
#pragma unroll
                for (int j = 0; j < 4; ++j) { acc[ai][1][m][0][j] *= gp[j] * frcp(gn[j]); acc[ai][1][m][1][j] *= gp[4 + j] * frcp(gn[4 + j]); } }
    }
    __device__ __forceinline__ void operator()(const f32x4 (&acc)[2][2][4][2], const Unit& u, int ui, PG8_LAS unsigned char* lds, int wr, int wc, int fr, int fq) const {
        const int row0 = u.pm * BM + wr * 64 + fr, col0 = u.pn * BM + wc * 32 + 8 * fq;
        const u32x4* tg = (const u32x4*)GT + ((size_t)(u.pm * 12 + 2 * 4 + u.pn) * 8) * 512 + ((wr * 4 + wc) * 64 + fq * 16 + fr);
        u32x4 wg[2][4];
#pragma unroll
        for (int ai = 0; ai < 2; ++ai)
#pragma unroll
            for (int m = 0; m < 4; ++m) wg[ai][m] = tg[(size_t)(ai * 4 + m) * 512];
#pragma unroll
        for (int ai = 0; ai < 2; ++ai)
#pragma unroll
            for (int m = 0; m < 4; ++m) { const size_t r = (size_t)(row0 + ai * HALF + m * 16);
#pragma unroll
                for (int bj = 0; bj < 2; ++bj) { float gl[8]; up4(bj ? wg[ai][m].z : wg[ai][m].x, gl, 0); up4(bj ? wg[ai][m].w : wg[ai][m].y, gl, 4);
                    const f32x4 v0 = acc[ai][bj][m][0], v1 = acc[ai][bj][m][1];
                    u32x4 w; w.x = cvtpk(v0[0] * gl[0], v0[1] * gl[1]); w.y = cvtpk(v0[2] * gl[2], v0[3] * gl[3]); w.z = cvtpk(v1[0] * gl[4], v1[1] * gl[5]); w.w = cvtpk(v1[2] * gl[6], v1[3] * gl[7]);
                    *(u32x4*)(O + r * D + col0 + bj * HALF) = w; } }
    }
};
template <bool A8OUT> struct EpiRes {
    static constexpr bool PERM = true, HAS_MID = false, HAS_PREP = A8OUT, HAS_COLTAB = false;
    const float* basef; const bf16_t* xr; bf16_t* xout; float* ssq; signed char* a8; float* qsinv; const float* ssqp;
    __device__ __forceinline__ void prep(PG8_LAS unsigned char* lds, int i, const Unit& u, int tid) const { if (a8 && tid < 256) *(PG8_LAS float*)(lds + RSTAB_OFF + (i * 256 + tid) * 4) = QCLIP * rstd_of(ssqp + (size_t)(u.pm * BM + tid) * 16); }
    __device__ __forceinline__ static void q8store(const f32x4& x0, const f32x4& x1, float qs, signed char* p) {
        constexpr float MAG = 12582912.f; unsigned t0[4], t1[4];
#pragma unroll
        for (int j = 0; j < 4; ++j) { t0[j] = __float_as_uint(__builtin_amdgcn_fmed3f(__builtin_fmaf(x0[j], qs, MAG), MAG - 127.f, MAG + 127.f)); t1[j] = __float_as_uint(__builtin_amdgcn_fmed3f(__builtin_fmaf(x1[j], qs, MAG), MAG - 127.f, MAG + 127.f)); }
        const unsigned lo = __builtin_amdgcn_perm(t0[1], t0[0], 0x0c0c0400u) | __builtin_amdgcn_perm(t0[3], t0[2], 0x04000c0cu);
        const unsigned hi = __builtin_amdgcn_perm(t1[1], t1[0], 0x0c0c0400u) | __builtin_amdgcn_perm(t1[3], t1[2], 0x04000c0cu);
        *(u32x2*)p = (u32x2){lo, hi}; }
    __device__ __forceinline__ void operator()(const f32x4 (&acc)[2][2][4][2], const Unit& u, int ui, PG8_LAS unsigned char* lds, int wr, int wc, int fr, int fq) const {
        const int row0 = u.pm * BM + wr * 64 + fr, col0 = u.pn * BM + wc * 32 + 8 * fq;
        u32x4 bw[8][2];
#define RES_LOAD(g) do { _Pragma("unroll") for (int bj = 0; bj < 2; ++bj) bw[g][bj] = *(const u32x4*)(xr + (size_t)(row0 + ((g) >> 2) * HALF + ((g) & 3) * 16) * D + col0 + bj * HALF); } while (0)
        RES_LOAD(0); RES_LOAD(1); RES_LOAD(2);
#pragma unroll
        for (int g = 0; g < 8; ++g) { const int ai = g >> 2, m = g & 3;
            if (g + 3 < 8) RES_LOAD(g + 3);
            const size_t r = (size_t)(row0 + ai * HALF + m * 16), off = r * D + col0; float sq = 0.f, qs = 0.f;
            if constexpr (A8OUT) { if (a8) qs = *(const PG8_LAS float*)(lds + RSTAB_OFF + ((ui >> 8) * 256 + wr * 64 + fr + ai * HALF + m * 16) * 4); }
#pragma unroll
            for (int bj = 0; bj < 2; ++bj) { const u32x4 b = bw[g][bj];
                const f32x4 x0 = (f32x4){bflo(b.x), bfhi(b.x), bflo(b.y), bfhi(b.y)} + acc[ai][bj][m][0], x1 = (f32x4){bflo(b.z), bfhi(b.z), bflo(b.w), bfhi(b.w)} + acc[ai][bj][m][1];
                sq += (x0[0] * x0[0] + x0[1] * x0[1]) + (x0[2] * x0[2] + x0[3] * x0[3]) + (x1[0] * x1[0] + x1[1] * x1[1]) + (x1[2] * x1[2] + x1[3] * x1[3]);
                u32x4 w; w.x = cvtpk(x0[0], x0[1]); w.y = cvtpk(x0[2], x0[3]); w.z = cvtpk(x1[0], x1[1]); w.w = cvtpk(x1[2], x1[3]);
                *(u32x4*)(xout + off + bj * HALF) = w;
                if constexpr (A8OUT) { if (a8) q8store(x0, x1, qs, a8 + r * 1024 + col0 + bj * HALF); } }
            if constexpr (A8OUT) { if (a8 && u.pn == 0 && wc == 0 && fq == 0) qsinv[r] = __builtin_amdgcn_rcpf(qs); }
            sq += __shfl_xor(sq, 16); sq += __shfl_xor(sq, 32);
            if (fq == 0) ssq[r * 16 + u.pn * 4 + wc] = sq; }
#undef RES_LOAD
    }
};
struct EpiFinal {
    static constexpr bool PERM = true, HAS_MID = false, HAS_PREP = false, HAS_COLTAB = false;
    const bf16_t* xr; float* out; float* slots; unsigned* cnt; const float* gv;
    __device__ __forceinline__ void operator()(f32x4 (&acc)[2][2][4][2], const Unit& u, int ui, PG8_LAS unsigned char* lds, int wr, int wc, int fr, int fq) const {
        const int row0 = u.pm * BM + wr * 64 + fr, col0 = u.pn * BM + wc * 32 + 8 * fq;
        u32x4 bw[8][2];
#define RES_LOAD(g) do { _Pragma("unroll") for (int bj = 0; bj < 2; ++bj) bw[g][bj] = *(const u32x4*)(xr + (size_t)(row0 + ((g) >> 2) * HALF + ((g) & 3) * 16) * D + col0 + bj * HALF); } while (0)
        RES_LOAD(0); RES_LOAD(1); RES_LOAD(2);
#pragma unroll
        for (int g = 0; g < 8; ++g) { const int ai = g >> 2, m = g & 3;
            if (g + 3 < 8) RES_LOAD(g + 3);
            const size_t r = (size_t)(row0 + ai * HALF + m * 16); float sq = 0.f;
#pragma unroll
            for (int bj = 0; bj < 2; ++bj) { const u32x4 b = bw[g][bj];
                const f32x4 x0 = (f32x4){bflo(b.x), bfhi(b.x), bflo(b.y), bfhi(b.y)} + acc[ai][bj][m][0], x1 = (f32x4){bflo(b.z), bfhi(b.z), bflo(b.w), bfhi(b.w)} + acc[ai][bj][m][1];
                sq += (x0[0] * x0[0] + x0[1] * x0[1]) + (x0[2] * x0[2] + x0[3] * x0[3]) + (x1[0] * x1[0] + x1[1] * x1[1]) + (x1[2] * x1[2] + x1[3] * x1[3]);
                acc[ai][bj][m][0] = x0; acc[ai][bj][m][1] = x1; }
            sq += __shfl_xor(sq, 16); sq += __shfl_xor(sq, 32);
            if (fq == 0) __hip_atomic_store(slots + r * 16 + u.pn * 4 + wc, sq, __ATOMIC_RELAXED, __HIP_MEMORY_SCOPE_AGENT); }
#undef RES_LOAD
        asm volatile("s_waitcnt vmcnt(0)" ::: "memory");
        unsigned* c = cnt + u.pm * 16;
        if (fr == 0 && fq == 0) (void)__hip_atomic_fetch_add(c, 1u, __ATOMIC_RELAXED, __HIP_MEMORY_SCOPE_AGENT);
        { unsigned sp = 0u; while (__hip_atomic_load(c, __ATOMIC_RELAXED, __HIP_MEMORY_SCOPE_AGENT) < 32u) { __builtin_amdgcn_s_sleep(2); if (++sp > (1u << 22)) break; } }
        asm volatile("" ::: "memory");
        f32x4 gq[2][2];
#pragma unroll
        for (int bj = 0; bj < 2; ++bj)
#pragma unroll
            for (int n = 0; n < 2; ++n) gq[bj][n] = *(const f32x4*)(gv + col0 + bj * HALF + 4 * n);
#pragma unroll
        for (int g = 0; g < 8; ++g) { const int ai = g >> 2, m = g & 3; const size_t r = (size_t)(row0 + ai * HALF + m * 16);
            const unsigned long long* sp = (const unsigned long long*)(slots + r * 16 + 4 * fq);
            const unsigned long long a = __hip_atomic_load(sp, __ATOMIC_RELAXED, __HIP_MEMORY_SCOPE_AGENT), b = __hip_atomic_load(sp + 1, __ATOMIC_RELAXED, __HIP_MEMORY_SCOPE_AGENT);
            float s = (__uint_as_float((unsigned)a) + __uint_as_float((unsigned)(a >> 32))) + (__uint_as_float((unsigned)b) + __uint_as_float((unsigned)(b >> 32)));
            s += __shfl_xor(s, 16); s += __shfl_xor(s, 32);
            const float rstd = 1.f / sqrtf(s * (1.f / D) + EPS);
#pragma unroll
            for (int bj = 0; bj < 2; ++bj)
#pragma unroll
                for (int n = 0; n < 2; ++n) *(f32x4*)(out + r * D + col0 + bj * HALF + 4 * n) = acc[ai][bj][m][n] * rstd * gq[bj][n]; }
    }
};
struct EpiSwiglu {
    static constexpr bool PERM = true, HAS_MID = false, HAS_PREP = true, HAS_COLTAB = true;
    bf16_t* H; const float* ssq; const float* qsinv; const float* cs;
    __device__ __forceinline__ void prep(PG8_LAS unsigned char* lds, int i, const Unit& u, int tid) const { if (tid < 256) { const size_t row = (size_t)(u.pm * BM + tid); *(PG8_LAS float*)(lds + RSTAB_OFF + (i * 256 + tid) * 4) = rstd_of(ssq + row * 16) * qsinv[row]; } }
    __device__ __forceinline__ void operator()(const f32x4 (&acc)[2][2][4][2], const Unit& u, int ui, PG8_LAS unsigned char* lds, int wr, int wc, int fr, int fq) const {
        const int row0 = u.pm * BM + wr * 64 + fr, col0 = u.pn * HALF + wc * 32 + 8 * fq, cc0 = u.pn * BM + wc * 32 + 8 * fq;
        f32x4 cf[2][2];
#pragma unroll
        for (int bj = 0; bj < 2; ++bj)
#pragma unroll
            for (int n = 0; n < 2; ++n) cf[bj][n] = *(const PG8_LAS f32x4*)(lds + CFTAB_OFF + (ui & 1) * 1024 + (wc * 32 + 8 * fq + bj * HALF + 4 * n) * 4);
#pragma unroll
        for (int ai = 0; ai < 2; ++ai)
#pragma unroll
            for (int m = 0; m < 4; ++m) { float o[8]; const float rs = *(const PG8_LAS float*)(lds + RSTAB_OFF + ((ui >> 8) * 256 + wr * 64 + fr + ai * HALF + m * 16) * 4);
#pragma unroll
                for (int n = 0; n < 2; ++n) { const i32x4 ig = __builtin_bit_cast(i32x4, acc[ai][0][m][n]), iu = __builtin_bit_cast(i32x4, acc[ai][1][m][n]); const f32x4 cg = cf[0][n] * rs, cu = cf[1][n] * rs;
#pragma unroll
                    for (int j = 0; j < 4; ++j) { const float gt = (float)ig[j] * cg[j], up = (float)iu[j] * cu[j]; o[4 * n + j] = gt * sigm(gt) * up; } }
                u32x4 w; w.x = cvtpk(o[0], o[1]); w.y = cvtpk(o[2], o[3]); w.z = cvtpk(o[4], o[5]); w.w = cvtpk(o[6], o[7]);
                *(u32x4*)(H + (size_t)(row0 + ai * HALF + m * 16) * FF + col0) = w; }
    }
};
}

typedef GAS unsigned gu32;
#define RLX_AGENT __ATOMIC_RELAXED, __HIP_MEMORY_SCOPE_AGENT
#define LDS_WAIT() asm volatile("s_waitcnt lgkmcnt(0)" ::: "memory")
#define VM_WAIT() asm volatile("s_waitcnt vmcnt(0)" ::: "memory")

#define XB_TMO      128
#define XB_XCNT(j)  (256  + 64 * (j))
#define XB_XSUB(j)  (1280 + 64 * (j))
#define XB_XGEN(j)  (2304 + 64 * (j))
#define XB_TOP      3328
#define XB_TOPGEN   3392
#define XCD_BAR_WORDS 3456
#define XB_SPIN_CAP (1u << 18)
__device__ __forceinline__ unsigned xb_ld(unsigned* p)              { return __hip_atomic_load(p, __ATOMIC_RELAXED, __HIP_MEMORY_SCOPE_AGENT); }
__device__ __forceinline__ unsigned xb_add(unsigned* p, unsigned v) { return __hip_atomic_fetch_add(p, v, __ATOMIC_RELAXED, __HIP_MEMORY_SCOPE_AGENT); }
__device__ __forceinline__ unsigned xb_xcc_id() { return (unsigned)__builtin_amdgcn_s_getreg((3 << 11) | 20) & 0xFu; }
#define XB_SPIN(cond, bar) do { unsigned _sp = 0; while (cond) { __builtin_amdgcn_s_sleep(1); \
    if ((++_sp & 255u) == 0u) { if (xb_ld(&(bar)[XB_TMO])) break; if (_sp > XB_SPIN_CAP) { atomicAdd(&(bar)[XB_TMO], 1u); break; } } } } while (0)
struct XcdBarrier { unsigned* bar; unsigned x; volatile LAS unsigned* st; };
__device__ __forceinline__ XcdBarrier xcd_barrier_post(unsigned* bar, volatile LAS unsigned* st) {
    XcdBarrier b; b.bar = bar; b.x = xb_xcc_id(); b.st = st;
    if (threadIdx.x == 0) (void)xb_add(&bar[XB_XCNT(b.x)], 1u);
    return b;
}
__device__ __forceinline__ void xcd_barrier_complete(unsigned* bar, unsigned x, unsigned& nloc, unsigned& nx) {
    const unsigned G = gridDim.x * gridDim.y * gridDim.z;
    unsigned sum, cnt, mine, sp = 0u;
    for (;;) {
        sum = 0u; cnt = 0u; mine = 0u;
#pragma unroll
        for (unsigned j = 0; j < 16; ++j) { const unsigned c = xb_ld(&bar[XB_XCNT(j)]); sum += c; cnt += (c > 0u) ? 1u : 0u; mine = (j == x) ? c : mine; }
        if (sum == G) break;
        __builtin_amdgcn_s_sleep(1);
        if ((++sp & 255u) == 0u) { if (xb_ld(&bar[XB_TMO])) break; if (sp > XB_SPIN_CAP) { atomicAdd(&bar[XB_TMO], 1u); break; } }
    }
    nloc = mine > 0u ? mine : 1u; nx = cnt > 0u ? cnt : 1u;
}
__device__ __forceinline__ void xcd_barrier(const XcdBarrier& b) {
    asm volatile("s_waitcnt vmcnt(0)" ::: "memory");
    __syncthreads();
    int tid_ = threadIdx.x; asm volatile("" : "+v"(tid_));
    if (tid_ == 0) {
        unsigned* bar = b.bar; unsigned bx_ = b.x;
        asm volatile("" : "+s"(bar), "+s"(bx_));
        __builtin_amdgcn_s_waitcnt(0);
        unsigned nloc = b.st[0], nx = b.st[1];
        if (nloc == 0u) { xcd_barrier_complete(bar, bx_, nloc, nx); b.st[0] = nloc; b.st[1] = nx; }
        const unsigned old = xb_add(&bar[XB_XSUB(bx_)], 1u);
        const unsigned gen = old / nloc;
        if (old + 1u == (gen + 1u) * nloc) {
            __builtin_amdgcn_fence(__ATOMIC_RELEASE, "agent");
            asm volatile("s_waitcnt vmcnt(0)" ::: "memory");
            const unsigned og = xb_add(&bar[XB_TOP], 1u);
            const unsigned tg = og / nx;
            if (og + 1u == (tg + 1u) * nx) xb_add(&bar[XB_TOPGEN], 1u);
            else XB_SPIN(xb_ld(&bar[XB_TOPGEN]) == tg, bar);
            __builtin_amdgcn_fence(__ATOMIC_ACQUIRE, "agent");
            xb_add(&bar[XB_XGEN(bx_)], 1u);
            asm volatile("s_waitcnt vmcnt(0)" ::: "memory");
        } else {
            XB_SPIN(xb_ld(&bar[XB_XGEN(bx_)]) == gen, bar);
            __builtin_amdgcn_fence(__ATOMIC_ACQUIRE, "agent");
            asm volatile("s_waitcnt vmcnt(0)" ::: "memory");
        }
    }
    __syncthreads();
}

constexpr int NWAVES = 8;
struct Frame {
    LAS unsigned char* lds;
    int tid0, wave, vcu, G;
    float* out; unsigned char* ws;
};
constexpr int PTR_OFF = LDSCTL_OFF + 128;
typedef const GAS float* gfp;
typedef const GAS f32x4* gf4p;
DI gfp inp(const Frame& F, int i) {
    unsigned a_ = (unsigned)(PTR_OFF + 8 * i); asm volatile("" : "+s"(a_));
    const v2u w = *(const LAS v2u*)(F.lds + a_);
    const unsigned long long p = ((unsigned long long)(unsigned)__builtin_amdgcn_readfirstlane((int)w.y) << 32) | (unsigned)__builtin_amdgcn_readfirstlane((int)w.x);
    return (gfp)p;
}
enum { I_X = 0, I_NMG, I_WIN, I_CLW, I_LWA, I_LBA, I_LWX, I_LBX, I_LAM, I_CMW, I_IGB, I_FGB, I_WOL, I_WOM, I_WOS, I_WO, I_NFG, I_WF1, I_WF2, I_FNG };

#define PHASE_IDS int tid = F.tid0; asm volatile("" : "+v"(tid)); const int lane = tid & 63
DI float wave_sum(float v) {
#pragma unroll
    for (int o = 1; o < 64; o <<= 1) v += __shfl_xor(v, o);
    return v;
}
DI float wave_max(float v) {
#pragma unroll
    for (int o = 1; o < 64; o <<= 1) v = fmaxf(v, __shfl_xor(v, o));
    return v;
}
DI unsigned short f2bf1(float x) { return (unsigned short)(cvtpk(x, 0.f) & 0xffffu); }
DI void unpack8(const v4u w, float (&x)[8]) { x[0] = bflo(w.x); x[1] = bfhi(w.x); x[2] = bflo(w.y); x[3] = bfhi(w.y); x[4] = bflo(w.z); x[5] = bfhi(w.z); x[6] = bflo(w.w); x[7] = bfhi(w.w); }
DI v4u pack8(const float (&x)[8]) { v4u w; w.x = cvtpk(x[0], x[1]); w.y = cvtpk(x[2], x[3]); w.z = cvtpk(x[4], x[5]); w.w = cvtpk(x[6], x[7]); return w; }

DI void tr_item(gfp src, int ld_src, bf16* dst, int ld_dst, LAS float* scr, int lane, gfp gain = nullptr) {
    f32x4 v[8]; float gk[8];
#pragma unroll
    for (int i = 0; i < 8; ++i) { v[i] = *(gf4p)(src + (size_t)((lane >> 3) + 8 * i) * ld_src + 4 * (lane & 7)); gk[i] = gain ? gain[(lane >> 3) + 8 * i] : 1.f; }
#pragma unroll
    for (int i = 0; i < 8; ++i) { LAS float* p = scr + ((lane >> 3) + 8 * i) * 33 + 4 * (lane & 7); p[0] = v[i].x * gk[i]; p[1] = v[i].y * gk[i]; p[2] = v[i].z * gk[i]; p[3] = v[i].w * gk[i]; }
    LDS_WAIT(); asm volatile("" ::: "memory");
    const int c = lane & 7;
#pragma unroll
    for (int j = 0; j < 4; ++j) { const int n = (lane >> 3) + 8 * j; const LAS float* s = scr + (8 * c) * 33 + n;
        v4u o; o.x = cvtpk(s[0 * 33], s[1 * 33]); o.y = cvtpk(s[2 * 33], s[3 * 33]); o.z = cvtpk(s[4 * 33], s[5 * 33]); o.w = cvtpk(s[6 * 33], s[7 * 33]);
        *(v4u*)(dst + (size_t)n * ld_dst + 8 * c) = o; }
    LDS_WAIT(); asm volatile("" ::: "memory");
}
DI void phase_weights(Frame& F, int l) {
    PHASE_IDS;
    LAS float* scr = (LAS float*)(F.lds + F.wave * 16384);
    const int gw = F.vcu * NWAVES + F.wave, NGW = F.G * NWAVES;
    unsigned char* wl = F.ws + WS_WL0 + (size_t)l * WS_WLSTRIDE;
    bf16* WIN = (bf16*)(wl + WO_WIN); bf16* WOUT = (bf16*)(wl + WO_WOUT); bf16* WO = (bf16*)(wl + WO_WO); bf16* WF1 = (bf16*)(wl + WO_WF1); bf16* WF2 = (bf16*)(wl + WO_WF2); bf16* LRUW = (bf16*)(wl + WO_LRUW);
    constexpr int N_WIN = 16 * 73, N_WOUT = 384, N_WO = 512, N_WF1 = 0  , N_WF2 = 44 * 32, N_LRU = 16;
    constexpr int NITEMS = N_WIN + N_WOUT + N_WO + N_WF1 + N_WF2 + N_LRU;
    for (int it = gw; it < NITEMS; it += NGW) {
        int r = it;
        if (r < N_WIN) { const int kb = r / 73, nb = r % 73, sc = (nb == 72) ? 1536 : 32 * nb + (32 * nb >= 1536 ? 8 : 0);
            tr_item(inp(F, I_WIN) + (size_t)l * D * IN_COLS + (size_t)(64 * kb) * IN_COLS + sc, IN_COLS, WIN + (size_t)(32 * nb) * D + 64 * kb, D, scr, lane, inp(F, I_NMG) + l * D + 64 * kb); continue; } r -= N_WIN;
        if (r < N_WOUT) { const int br = r / 128, rr = r % 128, kb = rr / 32, nb = rr % 32; gfp W = inp(F, br == 0 ? I_WOL : (br == 1 ? I_WOM : I_WOS));
            tr_item(W + (size_t)l * 256 * D + (size_t)(64 * kb) * D + 32 * nb, D, WOUT + (size_t)(32 * nb) * 768 + br * 256 + 64 * kb, 768, scr, lane); continue; } r -= N_WOUT;
        if (r < N_WO) { const int kb = r / 32, nb = r % 32;
            tr_item(inp(F, I_WO) + (size_t)l * D * D + (size_t)(64 * kb) * D + 32 * nb, D, WO + (size_t)(32 * nb) * D + 64 * kb, D, scr, lane); continue; } r -= N_WO;
        if (r < N_WF1) { const int kb = r / 176, nb = r % 176, pn = nb / 8, w = nb % 8, sc = (w < 4) ? 128 * pn + 32 * w : FF + 128 * pn + 32 * (w - 4);
            tr_item(inp(F, I_WF1) + (size_t)l * D * 2 * FF + (size_t)(64 * kb) * 2 * FF + sc, 2 * FF, WF1 + (size_t)(32 * nb) * D + 64 * kb, D, scr, lane, inp(F, I_NFG) + l * D + 64 * kb); continue; } r -= N_WF1;
        if (r < N_WF2) { const int kb = r / 32, nb = r % 32;
            tr_item(inp(F, I_WF2) + (size_t)l * FF * D + (size_t)(64 * kb) * D + 32 * nb, D, WF2 + (size_t)(32 * nb) * FF + 64 * kb, FF, scr, lane); continue; } r -= N_WF2;
        { const int gate = r / 8, g = (r / 2) % 4, nb = r % 2; gfp W = inp(F, gate ? I_LWX : I_LWA);
            tr_item(W + (size_t)l * 4 * 4096 + g * 4096 + 32 * nb, 64, LRUW + (size_t)((gate * 4 + g) * 64 + 32 * nb) * 64, 64, scr, lane); }
    }
}
DI void phase_w8(Frame& F) {
    PHASE_IDS;
    LAS float* scr = (LAS float*)(F.lds + F.wave * 16384); LAS float* CM = (LAS float*)(F.lds + 12288);
    for (int it = F.vcu; it < DEPTH * 272; it += F.G) {
        const int l = it / 272, ib = it % 272; const bool ffn = ib >= 96; const int nb = ffn ? ib - 96 : ib;
        const int ldw = ffn ? 2 * FF : IN_COLS;
        gfp src, gain; signed char* W8; float* CS;
        if (!ffn) { src = inp(F, I_WIN) + (size_t)l * D * IN_COLS + 2312 + 32 * nb; gain = inp(F, I_NMG) + l * D;
            W8 = (signed char*)(F.ws + WS_W8 + (size_t)l * 4 * MiB) + (size_t)(32 * nb) * 1024; CS = (float*)(F.ws + WS_W8 + (size_t)l * 4 * MiB + 3 * MiB) + 32 * nb; }
        else { const int pn = nb / 8, w = nb % 8, sc = (w < 4) ? 128 * pn + 32 * w : FF + 128 * pn + 32 * (w - 4);
            unsigned char* wl = F.ws + WS_WL0 + (size_t)l * WS_WLSTRIDE;
            src = inp(F, I_WF1) + (size_t)l * D * 2 * FF + sc; gain = inp(F, I_NFG) + l * D;
            W8 = (signed char*)(wl + WO_W8F) + (size_t)(32 * nb) * 1024; CS = (float*)(wl + WO_CSF) + 32 * nb; }
        f32x4 v[2][8]; float mx[4] = {0.f, 0.f, 0.f, 0.f};
#pragma unroll
        for (int h = 0; h < 2; ++h)
#pragma unroll
            for (int i = 0; i < 8; ++i) { const int k = 128 * F.wave + 64 * h + (lane >> 3) + 8 * i; v[h][i] = *(gf4p)(src + (size_t)k * ldw + 4 * (lane & 7)) * gain[k]; }
#pragma unroll
        for (int h = 0; h < 2; ++h)
#pragma unroll
            for (int i = 0; i < 8; ++i) { mx[0] = fmaxf(mx[0], fabsf(v[h][i].x)); mx[1] = fmaxf(mx[1], fabsf(v[h][i].y)); mx[2] = fmaxf(mx[2], fabsf(v[h][i].z)); mx[3] = fmaxf(mx[3], fabsf(v[h][i].w)); }
#pragma unroll
        for (int e = 0; e < 4; ++e) { mx[e] = fmaxf(mx[e], __shfl_xor(mx[e], 8)); mx[e] = fmaxf(mx[e], __shfl_xor(mx[e], 16)); mx[e] = fmaxf(mx[e], __shfl_xor(mx[e], 32)); }
        __syncthreads();
        if (lane < 8) { CM[F.wave * 32 + 4 * lane + 0] = mx[0]; CM[F.wave * 32 + 4 * lane + 1] = mx[1]; CM[F.wave * 32 + 4 * lane + 2] = mx[2]; CM[F.wave * 32 + 4 * lane + 3] = mx[3]; }
        __syncthreads();
        float sc[4];
#pragma unroll
        for (int e = 0; e < 4; ++e) { float m = 0.f;
#pragma unroll
            for (int w = 0; w < 8; ++w) m = fmaxf(m, CM[w * 32 + 4 * (lane & 7) + e]);
            m = fmaxf(m, 1e-30f); sc[e] = 127.f / m; if (F.wave == 0 && lane < 8) CS[4 * lane + e] = m * (1.f / 127.f); }
#pragma unroll
        for (int h = 0; h < 2; ++h) {
#pragma unroll
            for (int i = 0; i < 8; ++i) { LAS float* p = scr + ((lane >> 3) + 8 * i) * 33 + 4 * (lane & 7); p[0] = v[h][i].x * sc[0]; p[1] = v[h][i].y * sc[1]; p[2] = v[h][i].z * sc[2]; p[3] = v[h][i].w * sc[3]; }
            LDS_WAIT(); asm volatile("" ::: "memory");
#pragma unroll
            for (int c2 = 0; c2 < 2; ++c2) { const int id = lane + 64 * c2, n = id >> 2, kc = id & 3; unsigned w4[4];
#pragma unroll
                for (int q = 0; q < 4; ++q) { unsigned w = 0u;
#pragma unroll
                    for (int j = 0; j < 4; ++j) { const int qi = (int)rintf(scr[(16 * kc + 4 * q + j) * 33 + n]); w |= ((unsigned)qi & 0xffu) << (8 * j); }
                    w4[q] = w; }
                *(v4u*)(W8 + (size_t)n * 1024 + 128 * F.wave + 64 * h + 16 * kc) = (v4u){w4[0], w4[1], w4[2], w4[3]}; }
            LDS_WAIT(); asm volatile("" ::: "memory");
        }
    }
}
DI void phase_x0(Frame& F, gfp xsrc) {
    PHASE_IDS;
    const int gw = F.vcu * NWAVES + F.wave, NGW = F.G * NWAVES;
    bf16* XR = (bf16*)F.out; float* SSQ = (float*)(F.ws + WS_SSQ);
    for (int m = gw; m < M; m += NGW) {
        gf4p xr = (gf4p)(xsrc + (size_t)m * D) + lane;
        f32x4 v[4]; float s2 = 0.f;
#pragma unroll
        for (int j = 0; j < 4; ++j) { v[j] = xr[64 * j]; s2 += (v[j].x * v[j].x + v[j].y * v[j].y) + (v[j].z * v[j].z + v[j].w * v[j].w); }
        s2 = wave_sum(s2);
        v2u* o8 = (v2u*)(XR + (size_t)m * D) + lane;
#pragma unroll
        for (int j = 0; j < 4; ++j) { v2u w; w.x = cvtpk(v[j].x, v[j].y); w.y = cvtpk(v[j].z, v[j].w); o8[64 * j] = w; }
        if (lane < 16) SSQ[(size_t)m * 16 + lane] = (lane == 0) ? s2 : 0.f;
        {
            const float qs = QCLIP / sqrtf(s2 * (1.f / D) + EPS); unsigned* a8 = (unsigned*)(F.ws + WS_A8 + (size_t)m * 1024) + lane;
#pragma unroll
            for (int j = 0; j < 4; ++j) { const int q0 = (int)fminf(fmaxf(rintf(v[j].x * qs), -127.f), 127.f), q1 = (int)fminf(fmaxf(rintf(v[j].y * qs), -127.f), 127.f), q2 = (int)fminf(fmaxf(rintf(v[j].z * qs), -127.f), 127.f), q3 = (int)fminf(fmaxf(rintf(v[j].w * qs), -127.f), 127.f);
                a8[64 * j] = ((unsigned)q0 & 0xffu) | (((unsigned)q1 & 0xffu) << 8) | (((unsigned)q2 & 0xffu) << 16) | ((unsigned)q3 << 24); }
            if (lane == 0) ((float*)(F.ws + WS_QSINV))[m] = 1.f / qs; }
    }
}
DI void phase_final_norm(Frame& F, float* out, gfp gvec) {
    PHASE_IDS;
    const int gw = F.vcu * NWAVES + F.wave, NGW = F.G * NWAVES;
    f32x4 gv[4];
#pragma unroll
    for (int j = 0; j < 4; ++j) gv[j] = *((gf4p)gvec + lane + 64 * j);
    const float* SSQ = (const float*)(F.ws + WS_SSQ); const bf16* XF = (const bf16*)(F.ws + WS_XN);
    for (int m = gw; m < M; m += NGW) {
        f32x4* xr = (f32x4*)(out + (size_t)m * D) + lane; const v2u* xi = (const v2u*)(XF + (size_t)m * D) + lane;
        const float rstd = pg8::rstd_of(SSQ + (size_t)m * 16);
#pragma unroll
        for (int j = 0; j < 4; ++j) { const v2u w = xi[64 * j]; const f32x4 x = {bflo(w.x), bfhi(w.x), bflo(w.y), bfhi(w.y)}; xr[64 * j] = x * rstd * gv[j]; }
    }
}

DI void load_taps(const bf16* PROJ, int b, int pos, int col, v4u (&xk)[4]) {
#pragma unroll
    for (int k = 0; k < 4; ++k) { const int p = pos - 3 + k; xk[k] = (p >= 0) ? *(const v4u*)(PROJ + (size_t)(b * SEQ + p) * NP + col) : (v4u){0u, 0u, 0u, 0u}; }
}
constexpr int XA_PITCH = 528, LRU_GT_OFF = 128 * XA_PITCH;
static_assert(LRU_GT_OFF + 128 * XA_PITCH <= RSTAB_OFF, "LRU LDS map");
template <bool FINAL> DI void lru_item(Frame& F, int l, int b, int ci) {
    PHASE_IDS;
    bf16* PROJ = (bf16*)(F.ws + WS_PROJ); const bf16* LRUW = (const bf16*)(F.ws + WS_WL0 + (size_t)l * WS_WLSTRIDE + WO_LRUW); f32x2* LSUM = (f32x2*)(F.ws + WS_LSUM);
    LAS unsigned char* lds = F.lds;
    const int c8 = (tid & 31) * 8, t0 = tid >> 5;
    v4u gt[8];
    const int g = F.wave >> 1, jh = F.wave & 1, r = lane & 31, hh = lane >> 5, c = g * 64 + jh * 32 + r;
    bf16x8 wrf[4], wif[4];
#pragma unroll
    for (int ks = 0; ks < 4; ++ks) { wrf[ks] = *(const bf16x8*)(LRUW + (size_t)((0 * 4 + g) * 64 + jh * 32 + r) * 64 + 16 * ks + 8 * hh); wif[ks] = *(const bf16x8*)(LRUW + (size_t)((1 * 4 + g) * 64 + jh * 32 + r) * 64 + 16 * ks + 8 * hh); }
    const float ba = inp(F, I_LBA)[l * 256 + c], bx = inp(F, I_LBX)[l * 256 + c], lam = inp(F, I_LAM)[l * 256 + c];
    v4u xk[2][4][4];
#pragma unroll
    for (int hb = 0; hb < 2; ++hb)
#pragma unroll
        for (int i = 0; i < 4; ++i) load_taps(PROJ, b, ci * LCH + t0 + 16 * (4 * hb + i), C_LX + c8, xk[hb][i]);
    __syncthreads();
    {
        gfp cw = inp(F, I_CLW) + l * 1024 + c8;
#pragma unroll
        for (int hb = 0; hb < 2; ++hb) {
#pragma unroll
            for (int i = 0; i < 4; ++i) { float acc[8];
#pragma unroll
                for (int e = 0; e < 8; ++e) acc[e] = 0.f;
#pragma unroll
                for (int k = 0; k < 4; ++k) { float x[8]; unpack8(xk[hb][i][k], x); const f32x4 wa = *(gf4p)(cw + k * 256), wb = *(gf4p)(cw + k * 256 + 4);
                    acc[0] += wa.x * x[0]; acc[1] += wa.y * x[1]; acc[2] += wa.z * x[2]; acc[3] += wa.w * x[3]; acc[4] += wb.x * x[4]; acc[5] += wb.y * x[5]; acc[6] += wb.z * x[6]; acc[7] += wb.w * x[7]; }
                *(LAS v4u*)(lds + (t0 + 16 * (4 * hb + i)) * XA_PITCH + c8 * 2) = pack8(acc); } }
    }
    if (FINAL) {
#pragma unroll
        for (int i = 0; i < 8; ++i) gt[i] = *(const v4u*)(PROJ + (size_t)(b * SEQ + ci * LCH + t0 + 16 * i) * NP + C_LG + c8);
    }
    if (FINAL) {
        const int j0 = (ci * F.wave) / 8, j1 = (ci * (F.wave + 1)) / 8;
        float A[4] = {1.f, 1.f, 1.f, 1.f}, Bv[4] = {0.f, 0.f, 0.f, 0.f};
        for (int j = j0; j < j1; j += 8) { f32x2 sm[8][4];
#pragma unroll
            for (int jj = 0; jj < 8; ++jj) { const int jc = (j + jj < j1) ? j + jj : j1 - 1;
#pragma unroll
                for (int q = 0; q < 4; ++q) sm[jj][q] = LSUM[(size_t)(b * NLCH + jc) * 256 + lane + 64 * q]; }
#pragma unroll
            for (int jj = 0; jj < 8; ++jj) if (j + jj < j1) {
#pragma unroll
                for (int q = 0; q < 4; ++q) { Bv[q] = sm[jj][q].x * Bv[q] + sm[jj][q].y; A[q] *= sm[jj][q].x; } } }
#pragma unroll
        for (int q = 0; q < 4; ++q) *(LAS f32x2*)(lds + LRU_GT_OFF + (F.wave * 256 + lane + 64 * q) * 8) = (f32x2){A[q], Bv[q]};
    }
    __syncthreads();
    const float sp8 = 8.f * softplus(-lam);
    float carry = 0.f, Atot = 1.f;
    if (FINAL) {
#pragma unroll
        for (int w = 0; w < 8; ++w) { const f32x2 p = *(const LAS f32x2*)(lds + LRU_GT_OFF + (w * 256 + c) * 8); carry = p.x * carry + p.y; }
        __syncthreads();
#pragma unroll
        for (int i = 0; i < 8; ++i) *(LAS v4u*)(lds + LRU_GT_OFF + (t0 + 16 * i) * XA_PITCH + c8 * 2) = gt[i];
        __syncthreads();
    }
    for (int tt = 0; tt < 4; ++tt) {
        f32x16 accr, acci;
#pragma unroll
        for (int i = 0; i < 16; ++i) { accr[i] = 0.f; acci[i] = 0.f; }
#pragma unroll
        for (int ks = 0; ks < 4; ++ks) { const bf16x8 a = *(const LAS bf16x8*)(lds + (tt * 32 + tau(r)) * XA_PITCH + (g * 64 + 16 * ks + 8 * hh) * 2); accr = MFMA32(a, wrf[ks], accr); acci = MFMA32(a, wif[ks], acci); }
        float HL[16], PP[16]; float hl = 0.f, pp = 1.f;
#pragma unroll
        for (int reg = 0; reg < 16; ++reg) {
            const float xv = bf2f(*(const LAS unsigned short*)(lds + (tt * 32 + 16 * hh + reg) * XA_PITCH + c * 2));
            const float rg = sigm(accr[reg] + ba), ig = sigm(acci[reg] + bx), la = -sp8 * rg, a = fexp(la), u = __builtin_amdgcn_sqrtf(fmaxf(1.f - a * a, 0.f)) * ig * xv;
            hl = a * hl + u; pp = pp * a; HL[reg] = hl; PP[reg] = pp; }
        const float e0h = __shfl(hl, r), e0p = __shfl(pp, r), e1h = __shfl(hl, r + 32), e1p = __shfl(pp, r + 32);
        const float end0 = e0h + e0p * carry, end1 = e1h + e1p * end0, enter = hh ? end0 : carry;
        carry = end1; Atot *= e0p * e1p;
        if (FINAL) {
#pragma unroll
            for (int reg = 0; reg < 16; ++reg) { const float hv = HL[reg] + PP[reg] * enter; LAS unsigned short* gp = (LAS unsigned short*)(lds + LRU_GT_OFF + (tt * 32 + 16 * hh + reg) * XA_PITCH + c * 2);
                *gp = f2bf1(hv * gelu_tanh(bf2f(*gp))); }
        }
    }
    if (!FINAL) { if (hh == 0) LSUM[(size_t)(b * NLCH + ci) * 256 + c] = (f32x2){Atot, carry}; }
    else {
        __syncthreads();
#pragma unroll
        for (int i = 0; i < 8; ++i) { const size_t row = (size_t)(b * SEQ + ci * LCH + t0 + 16 * i);
            *(v4u*)(PROJ + row * NP + C_LG + c8) = *(const LAS v4u*)(lds + LRU_GT_OFF + (t0 + 16 * i) * XA_PITCH + c8 * 2); }
    }
}

constexpr int CW_LRU = 12288;
DI void lru_item_sp(Frame& F, int l, int b, int ci) {
    PHASE_IDS;
    bf16* PROJ = (bf16*)(F.ws + WS_PROJ); const bf16* LRUW = (const bf16*)(F.ws + WS_WL0 + (size_t)l * WS_WLSTRIDE + WO_LRUW);
    unsigned long long* LSUM = (unsigned long long*)(F.ws + WS_LSUM); unsigned* LCNT = (unsigned*)(F.ws + WS_CTL) + CW_LRU;
    LAS unsigned char* lds = F.lds;
    const int c8 = (tid & 31) * 8, t0 = tid >> 5;
    const int g = F.wave >> 1, jh = F.wave & 1, r = lane & 31, hh = lane >> 5, c = g * 64 + jh * 32 + r;
    bf16x8 wrf[4], wif[4];
#pragma unroll
    for (int ks = 0; ks < 4; ++ks) { wrf[ks] = *(const bf16x8*)(LRUW + (size_t)((0 * 4 + g) * 64 + jh * 32 + r) * 64 + 16 * ks + 8 * hh); wif[ks] = *(const bf16x8*)(LRUW + (size_t)((1 * 4 + g) * 64 + jh * 32 + r) * 64 + 16 * ks + 8 * hh); }
    const float ba = inp(F, I_LBA)[l * 256 + c], bx = inp(F, I_LBX)[l * 256 + c], lam = inp(F, I_LAM)[l * 256 + c];
    v4u xk[2][4][4];
#pragma unroll
    for (int hb = 0; hb < 2; ++hb)
#pragma unroll
        for (int i = 0; i < 4; ++i) load_taps(PROJ, b, ci * LCH + t0 + 16 * (4 * hb + i), C_LX + c8, xk[hb][i]);
    __syncthreads();
    {
        gfp cw = inp(F, I_CLW) + l * 1024 + c8;
#pragma unroll
        for (int hb = 0; hb < 2; ++hb) {
#pragma unroll
            for (int i = 0; i < 4; ++i) { float acc[8];
#pragma unroll
                for (int e = 0; e < 8; ++e) acc[e] = 0.f;
#pragma unroll
                for (int k = 0; k < 4; ++k) { float x[8]; unpack8(xk[hb][i][k], x); const f32x4 wa = *(gf4p)(cw + k * 256), wb = *(gf4p)(cw + k * 256 + 4);
                    acc[0] += wa.x * x[0]; acc[1] += wa.y * x[1]; acc[2] += wa.z * x[2]; acc[3] += wa.w * x[3]; acc[4] += wb.x * x[4]; acc[5] += wb.y * x[5]; acc[6] += wb.z * x[6]; acc[7] += wb.w * x[7]; }
                *(LAS v4u*)(lds + (t0 + 16 * (4 * hb + i)) * XA_PITCH + c8 * 2) = pack8(acc); } }
    }
    {
        v4u gt[8];
#pragma unroll
        for (int i = 0; i < 8; ++i) gt[i] = *(const v4u*)(PROJ + (size_t)(b * SEQ + ci * LCH + t0 + 16 * i) * NP + C_LG + c8);
#pragma unroll
        for (int i = 0; i < 8; ++i) *(LAS v4u*)(lds + LRU_GT_OFF + (t0 + 16 * i) * XA_PITCH + c8 * 2) = gt[i];
    }
    __syncthreads();
    const float sp8 = 8.f * softplus(-lam);
    float HL[4][16], EH0[4], EP0[4], EH1[4], EP1[4]; unsigned PPk[4][8];
    float carry = 0.f, Atot = 1.f;
#pragma unroll
    for (int tt = 0; tt < 4; ++tt) {
        f32x16 accr, acci;
#pragma unroll
        for (int i = 0; i < 16; ++i) { accr[i] = 0.f; acci[i] = 0.f; }
#pragma unroll
        for (int ks = 0; ks < 4; ++ks) { const bf16x8 a = *(const LAS bf16x8*)(lds + (tt * 32 + tau(r)) * XA_PITCH + (g * 64 + 16 * ks + 8 * hh) * 2); accr = MFMA32(a, wrf[ks], accr); acci = MFMA32(a, wif[ks], acci); }
        float hl = 0.f, pp = 1.f, ppv[16];
#pragma unroll
        for (int reg = 0; reg < 16; ++reg) {
            const float xv = bf2f(*(const LAS unsigned short*)(lds + (tt * 32 + 16 * hh + reg) * XA_PITCH + c * 2));
            const float rg = sigm(accr[reg] + ba), ig = sigm(acci[reg] + bx), la = -sp8 * rg, a = fexp(la), u = __builtin_amdgcn_sqrtf(fmaxf(1.f - a * a, 0.f)) * ig * xv;
            hl = a * hl + u; pp = pp * a; HL[tt][reg] = hl; ppv[reg] = pp; }
#pragma unroll
        for (int q = 0; q < 8; ++q) PPk[tt][q] = cvtpk(ppv[2 * q], ppv[2 * q + 1]);
        const float e0h = __shfl(hl, r), e0p = __shfl(pp, r), e1h = __shfl(hl, r + 32), e1p = __shfl(pp, r + 32);
        EH0[tt] = e0h; EP0[tt] = e0p; EH1[tt] = e1h; EP1[tt] = e1p;
        const float end0 = e0h + e0p * carry, end1 = e1h + e1p * end0;
        carry = end1; Atot *= e0p * e1p;
    }
    if (hh == 0) __hip_atomic_store(LSUM + (size_t)(b * NLCH + ci) * 256 + c, ((unsigned long long)__float_as_uint(carry) << 32) | __float_as_uint(Atot), __ATOMIC_RELAXED, __HIP_MEMORY_SCOPE_AGENT);
    asm volatile("s_waitcnt vmcnt(0)" ::: "memory");
    if (lane == 0) (void)__hip_atomic_fetch_add(LCNT + (b * NLCH + ci) * 4, 1u, __ATOMIC_RELAXED, __HIP_MEMORY_SCOPE_AGENT);
    __syncthreads();
    {
        const int j0 = (ci * F.wave) / 8, j1 = (ci * (F.wave + 1)) / 8; const unsigned target = 8u * (unsigned)(l + 1);
        if (lane < j1 - j0) { unsigned* cp = LCNT + (b * NLCH + j0 + lane) * 4; unsigned sp = 0u;
            while (__hip_atomic_load(cp, __ATOMIC_RELAXED, __HIP_MEMORY_SCOPE_AGENT) < target) { __builtin_amdgcn_s_sleep(1); if (++sp > (1u << 22)) break; } }
        asm volatile("" ::: "memory");
        float A[4] = {1.f, 1.f, 1.f, 1.f}, Bv[4] = {0.f, 0.f, 0.f, 0.f};
        for (int j = j0; j < j1; j += 8) { unsigned long long sm[8][4];
#pragma unroll
            for (int jj = 0; jj < 8; ++jj) { const int jc = (j + jj < j1) ? j + jj : j1 - 1;
#pragma unroll
                for (int q = 0; q < 4; ++q) sm[jj][q] = __hip_atomic_load(LSUM + (size_t)(b * NLCH + jc) * 256 + lane + 64 * q, __ATOMIC_RELAXED, __HIP_MEMORY_SCOPE_AGENT); }
#pragma unroll
            for (int jj = 0; jj < 8; ++jj) if (j + jj < j1) {
#pragma unroll
                for (int q = 0; q < 4; ++q) { const float sa = __uint_as_float((unsigned)sm[jj][q]), sb = __uint_as_float((unsigned)(sm[jj][q] >> 32)); Bv[q] = sa * Bv[q] + sb; A[q] *= sa; } } }
#pragma unroll
        for (int q = 0; q < 4; ++q) *(LAS f32x2*)(lds + (F.wave * 256 + lane + 64 * q) * 8) = (f32x2){A[q], Bv[q]};
    }
    __syncthreads();
    carry = 0.f;
#pragma unroll
    for (int w = 0; w < 8; ++w) { const f32x2 p = *(const LAS f32x2*)(lds + (w * 256 + c) * 8); carry = p.x * carry + p.y; }
#pragma unroll
    for (int tt = 0; tt < 4; ++tt) {
        const float end0 = EH0[tt] + EP0[tt] * carry, end1 = EH1[tt] + EP1[tt] * end0, enter = hh ? end0 : carry;
        carry = end1;
#pragma unroll
        for (int reg = 0; reg < 16; ++reg) { const unsigned pw = PPk[tt][reg >> 1]; const float hv = HL[tt][reg] + ((reg & 1) ? bfhi(pw) : bflo(pw)) * enter; LAS unsigned short* gp = (LAS unsigned short*)(lds + LRU_GT_OFF + (tt * 32 + 16 * hh + reg) * XA_PITCH + c * 2);
            *gp = f2bf1(hv * gelu_tanh(bf2f(*gp))); }
    }
    __syncthreads();
    int t0s = t0; asm volatile("" : "+v"(t0s));
#pragma unroll
    for (int i = 0; i < 8; ++i) { const size_t row = (size_t)(b * SEQ + ci * LCH + t0s + 16 * i);
        *(v4u*)(PROJ + row * NP + C_LG + c8) = *(const LAS v4u*)(lds + LRU_GT_OFF + (t0s + 16 * i) * XA_PITCH + c8 * 2); }
}

DI float scan_add(float x, int lane) {
#pragma unroll
    for (int o = 1; o < 64; o <<= 1) { const float t = __shfl_up(x, o); if (lane >= o) x += t; }
    return x;
}
DI float scan_max(float x, int lane) {
#pragma unroll
    for (int o = 1; o < 64; o <<= 1) { const float t = __shfl_up(x, o); if (lane >= o) x = fmaxf(x, t); }
    return x;
}
DI void conv8_silu(const bf16* PROJ, int b, int pos, int col, const float (&w)[4][8], float scale, float (&o)[8]) {
#pragma unroll
    for (int e = 0; e < 8; ++e) o[e] = 0.f;
#pragma unroll
    for (int k = 0; k < 4; ++k) { const int p = pos - 3 + k; if (p >= 0) { float x[8]; unpack8(*(const v4u*)(PROJ + (size_t)(b * SEQ + p) * NP + col), x);
#pragma unroll
        for (int e = 0; e < 8; ++e) o[e] += w[k][e] * x[e]; } }
#pragma unroll
    for (int e = 0; e < 8; ++e) o[e] = siluf(o[e]) * scale;
}
DI void load_cw(gfp cw, float (&w)[4][8]) {
#pragma unroll
    for (int k = 0; k < 4; ++k) { const f32x4 a = *(gf4p)(cw + k * 512), c = *(gf4p)(cw + k * 512 + 4);
        w[k][0] = a.x; w[k][1] = a.y; w[k][2] = a.z; w[k][3] = a.w; w[k][4] = c.x; w[k][5] = c.y; w[k][6] = c.z; w[k][7] = c.w; }
}
DI void conv8_regs(const v4u (&xk)[4], gfp cw  , float scale, float (&o)[8]) {
#pragma unroll
    for (int e = 0; e < 8; ++e) o[e] = 0.f;
#pragma unroll
    for (int k = 0; k < 4; ++k) { float x[8]; unpack8(xk[k], x); const f32x4 a = *(gf4p)(cw + k * 512), c = *(gf4p)(cw + k * 512 + 4);
        o[0] += a.x * x[0]; o[1] += a.y * x[1]; o[2] += a.z * x[2]; o[3] += a.w * x[3]; o[4] += c.x * x[4]; o[5] += c.y * x[5]; o[6] += c.z * x[6]; o[7] += c.w * x[7]; }
#pragma unroll
    for (int e = 0; e < 8; ++e) o[e] = siluf(o[e]) * scale;
}
#define GATHER8(dst, base, pitch, col, ROWEXPR) do { unsigned g_[8]; _Pragma("unroll") for (int j = 0; j < 8; ++j) g_[j] = *(const LAS unsigned short*)((base) + (ROWEXPR) * (pitch) + (col) * 2); \
    v4u w_; w_.x = g_[0] | (g_[1] << 16); w_.y = g_[2] | (g_[3] << 16); w_.z = g_[4] | (g_[5] << 16); w_.w = g_[6] | (g_[7] << 16); dst = __builtin_bit_cast(bf16x8, w_); } while (0)
constexpr int M1_HB = 20480;
DI void m1_item(Frame& F, int l, int b, int cm) {
    PHASE_IDS;
    const bf16* PROJ = (const bf16*)(F.ws + WS_PROJ); const float* IFB = (const float*)(F.ws + WS_IF);
    float* BL = (float*)(F.ws + WS_MSC); float* GG = BL + 2048; float* MST = (float*)(F.ws + WS_MST); float* MSN = (float*)(F.ws + WS_MSN);
    LAS unsigned char* lds = F.lds;
    const int hd = F.wave >> 1, sub = F.wave & 1, r = lane & 31, hh = lane >> 5;
    const int c8i = tid & 31, cc = c8i * 8, head = c8i >> 3, d0 = (c8i & 7) * 8, s0 = tid >> 5;
    v4u xk[4][4], xv[4];
#pragma unroll
    for (int i = 0; i < 4; ++i) { const int pos = cm * MCH + s0 + 16 * i; load_taps(PROJ, b, pos, C_MK + cc, xk[i]); xv[i] = *(const v4u*)(PROJ + (size_t)(b * SEQ + pos) * NP + C_MV + cc); }
    float ip = 0.f, lf = 0.f;
    if (sub == 0) { const size_t row = (size_t)b * SEQ + cm * MCH + lane; ip = IFB[row * 8 + hd]; lf = IFB[row * 8 + 4 + hd]; }
    __syncthreads();
    if (sub == 0) {
        const float bs = scan_add(lf, lane), bL = __shfl(bs, 63), gs = bL - bs + ip, G = wave_max(gs);
        *(LAS float*)(lds + hd * M1_HB + 18432 + lane * 4) = fexp(gs - G);
        if (lane == 0) { BL[(b * 4 + hd) * NMCH + cm] = bL; GG[(b * 4 + hd) * NMCH + cm] = G; }
    }
    { gfp cw = inp(F, I_CMW) + l * 2048 + 256 + cc; LAS unsigned char* hbs = lds + head * M1_HB;
#pragma unroll
      for (int i = 0; i < 4; ++i) { float kv[8]; conv8_regs(xk[i], cw, 0.125f, kv); *(LAS v4u*)(hbs + (s0 + 16 * i) * 144 + d0 * 2) = pack8(kv); } }
    __syncthreads();
    { LAS unsigned char* hbs = lds + head * M1_HB;
#pragma unroll
      for (int i = 0; i < 4; ++i) { const int sidx = s0 + 16 * i; const float ws = *(const LAS float*)(hbs + 18432 + sidx * 4); float vv[8]; unpack8(xv[i], vv);
#pragma unroll
        for (int e = 0; e < 8; ++e) vv[e] *= ws;
        *(LAS v4u*)(hbs + 9216 + sidx * 144 + d0 * 2) = pack8(vv); } }
    __syncthreads();
    {
        LAS unsigned char* hb = lds + hd * M1_HB; const int vt = sub; const size_t base = ((size_t)(b * 4 + hd) * NMCH + cm) * 4096;
        bf16x8 af[4];
#pragma unroll
        for (int ks = 0; ks < 4; ++ks) GATHER8(af[ks], hb + 9216, 144, vt * 32 + r, (16 * ks + 8 * hh + j));
#pragma unroll
        for (int kt = 0; kt < 2; ++kt) { f32x16 acc;
#pragma unroll
            for (int i = 0; i < 16; ++i) acc[i] = 0.f;
#pragma unroll
            for (int ks = 0; ks < 4; ++ks) { bf16x8 bb; GATHER8(bb, hb, 144, kt * 32 + r, (16 * ks + 8 * hh + j)); acc = MFMA32(af[ks], bb, acc); }
#pragma unroll
            for (int reg = 0; reg < 16; ++reg) MST[base + (size_t)(vt * 32 + crow(reg, hh)) * 64 + kt * 32 + r] = acc[reg]; }
        if (tid < 256) { const int hd2 = tid >> 6, k = tid & 63; LAS unsigned char* h2 = lds + hd2 * M1_HB; float sm = 0.f;
#pragma unroll 8
            for (int sidx = 0; sidx < 64; ++sidx) sm += bf2f(*(const LAS unsigned short*)(h2 + sidx * 144 + k * 2)) * *(const LAS float*)(h2 + 18432 + sidx * 4);
            MSN[((size_t)(b * 4 + hd2) * NMCH + cm) * 64 + k] = sm; }
    }
}
DI void m2_scan(Frame& F) {
    PHASE_IDS;
    LAS unsigned char* lds = F.lds;
    LAS float* TH = (LAS float*)lds; LAS float* MM = TH + 256; LAS float* WA = MM + 272; LAS float* WB = WA + 256; LAS float* WT = WB + 256; LAS float* TT = WT + 256;
    const int bh = F.vcu >> 5, e0 = (F.vcu & 31) * 130;
    if (F.vcu >= 256) return;
    const float* BLp = (const float*)(F.ws + WS_MSC) + bh * NMCH; const float* GGp = BLp + 2048; float* MAp = (float*)(F.ws + WS_MSC) + 4096 + bh * NMCH;
    __syncthreads();
    if (F.wave == 0) {
        float bl[4], gg[4], bi[4]; float tot = 0.f;
#pragma unroll
        for (int i = 0; i < 4; ++i) { bl[i] = BLp[4 * lane + i]; gg[i] = GGp[4 * lane + i]; tot += bl[i]; bi[i] = tot; }
        const float incl = scan_add(tot, lane), base = incl - tot;
        float th[4]; float lmax = -3.0e38f;
#pragma unroll
        for (int i = 0; i < 4; ++i) { th[i] = gg[i] - (base + bi[i]); lmax = fmaxf(lmax, th[i]); }
        const float imax = scan_max(lmax, lane); float ex = __shfl_up(imax, 1); if (lane == 0) ex = 0.f; float m = fmaxf(ex, 0.f);
#pragma unroll
        for (int i = 0; i < 4; ++i) { const int c = 4 * lane + i; TH[c] = th[i]; MM[c] = m; if ((F.vcu & 31) == 0) MAp[c] = (base + bi[i] - bl[i]) + m; m = fmaxf(m, th[i]); }
        if (lane == 63) MM[256] = m;
    }
    __syncthreads();
    const int j = tid >> 5, el = tid & 31;
    float x[5][16]; float* ptr[5];
#pragma unroll
    for (int g = 0; g < 5; ++g) { const int eo = g * 32 + el; const bool valid = eo < 130; const int e = e0 + (valid ? eo : 0);
        ptr[g] = (e < 4096) ? (float*)(F.ws + WS_MST) + ((size_t)bh * NMCH + 16 * j) * 4096 + e : (float*)(F.ws + WS_MSN) + ((size_t)bh * NMCH + 16 * j) * 64 + (e - 4096);
        const size_t stride = (e < 4096) ? 4096 : 64;
#pragma unroll
        for (int i = 0; i < 16; ++i) x[g][i] = ptr[g][(size_t)i * stride]; }
    if (tid < 256) { const int c = tid; const float m1 = MM[c + 1]; WA[c] = fexp(MM[c] - m1); WB[c] = fexp(TH[c] - m1); WT[c] = fexp(TH[c] - MM[(c | 15) + 1]); }
    else if (tid < 271) { const int jj = tid - 256; MM[257 + jj] = fexp(MM[16 * jj] - MM[16 * jj + 16]); }
    __syncthreads();
#pragma unroll
    for (int g = 0; g < 5; ++g) {
        float T = 0.f;
#pragma unroll
        for (int i = 0; i < 16; ++i) T += WT[16 * j + i] * x[g][i];
        TT[(g * 16 + j) * 32 + el] = T; }
    __syncthreads();
#pragma unroll
    for (int g = 0; g < 5; ++g) { const int eo = g * 32 + el; const bool valid = eo < 130; const int e = e0 + (valid ? eo : 0); const size_t stride = (e < 4096) ? 4096 : 64;
        float st = 0.f;
        for (int jj = 0; jj < j; ++jj) st = MM[257 + jj] * st + TT[(g * 16 + jj) * 32 + el];
        if (valid) {
#pragma unroll
            for (int i = 0; i < 16; ++i) { const int c = 16 * j + i; ptr[g][(size_t)i * stride] = st; st = WA[c] * st + WB[c] * x[g][i]; } }
    }
    __syncthreads();
}
constexpr int M3_HB = 28672;
DI void m3_item(Frame& F, int l, int b, int cm) {
    PHASE_IDS;
    bf16* PROJ = (bf16*)(F.ws + WS_PROJ); const float* IFB = (const float*)(F.ws + WS_IF);
    const float* MARR = (const float*)(F.ws + WS_MSC) + 4096; const float* MST = (const float*)(F.ws + WS_MST); const float* MSN = (const float*)(F.ws + WS_MSN);
    LAS unsigned char* lds = F.lds;
    const int hd = F.wave >> 1, sub = F.wave & 1, r = lane & 31, hh = lane >> 5;
    const int c8i = tid & 31, cc = c8i * 8, head = c8i >> 3, d0 = (c8i & 7) * 8, s0 = tid >> 5; LAS unsigned char* hbs = lds + head * M3_HB;
    v4u xq[4][4], xk2[4][4], xv[4];
#pragma unroll
    for (int i = 0; i < 4; ++i) { const int pos = cm * MCH + s0 + 16 * i; load_taps(PROJ, b, pos, C_MQ + cc, xq[i]); load_taps(PROJ, b, pos, C_MK + cc, xk2[i]); xv[i] = *(const v4u*)(PROJ + (size_t)(b * SEQ + pos) * NP + C_MV + cc); }
    float ip = 0.f, lf = 0.f; const float mprev0 = MARR[(b * 4 + hd) * NMCH + cm];
    if (sub == 0) { const size_t row = (size_t)b * SEQ + cm * MCH + lane; ip = IFB[row * 8 + hd]; lf = IFB[row * 8 + 4 + hd]; }
    v4u gq[4];
#pragma unroll
    for (int i = 0; i < 4; ++i) gq[i] = *(const v4u*)(PROJ + (size_t)(b * SEQ + cm * MCH + s0 + 16 * i) * NP + C_MO + cc);
    __syncthreads();
    if (sub == 0) {
        const float bs = scan_add(lf, lane), es = ip - bs, em = scan_max(es, lane), mh = fmaxf(em, mprev0);
        LAS float* t = (LAS float*)(lds + hd * M3_HB + 27648); t[lane] = es; t[64 + lane] = mh; t[128 + lane] = bs;
    }
#pragma unroll
    for (int i = 0; i < 4; ++i) { float qv[8]; conv8_regs(xq[i], inp(F, I_CMW) + l * 2048 + cc, 1.f, qv); *(LAS v4u*)(hbs + (s0 + 16 * i) * 144 + d0 * 2) = pack8(qv); *(LAS v4u*)(hbs + 18432 + (s0 + 16 * i) * 144 + d0 * 2) = xv[i]; }
#pragma unroll
    for (int i = 0; i < 4; ++i) { float kv[8]; conv8_regs(xk2[i], inp(F, I_CMW) + l * 2048 + 256 + cc, 0.125f, kv); *(LAS v4u*)(hbs + 9216 + (s0 + 16 * i) * 144 + d0 * 2) = pack8(kv); }
    f32x4 cfr[2][4][2], nfr[8];
    { const float* Cst = MST + ((size_t)(b * 4 + hd) * NMCH + cm) * 4096; const float* nst = MSN + ((size_t)(b * 4 + hd) * NMCH + cm) * 64 + 32 * hh;
#pragma unroll
      for (int vt = 0; vt < 2; ++vt)
#pragma unroll
        for (int ks = 0; ks < 4; ++ks) { cfr[vt][ks][0] = *(const f32x4*)(Cst + (size_t)(vt * 32 + r) * 64 + 16 * ks + 8 * hh); cfr[vt][ks][1] = *(const f32x4*)(Cst + (size_t)(vt * 32 + r) * 64 + 16 * ks + 8 * hh + 4); }
#pragma unroll
      for (int q = 0; q < 8; ++q) nfr[q] = *(const f32x4*)(nst + 4 * q); }
    __syncthreads();
    f32x16 outv[2];
    {
        LAS unsigned char* hb = lds + hd * M3_HB; const LAS float* tb = (const LAS float*)(hb + 27648);
        const int tw = sub, t = tw * 32 + r; const int bh = b * 4 + hd;
        bf16x8 qf[4];
#pragma unroll
        for (int ks = 0; ks < 4; ++ks) qf[ks] = *(const LAS bf16x8*)(hb + (tw * 32 + r) * 144 + (16 * ks + 8 * hh) * 2);
        const float mh = tb[64 + t], bt = tb[128 + t], mprev = mprev0, decay = fexp(mprev - mh);
        f32x16 accN[2], accI[2];
#pragma unroll
        for (int i = 0; i < 16; ++i) { accN[0][i] = 0.f; accN[1][i] = 0.f; accI[0][i] = 0.f; accI[1][i] = 0.f; }
        float dsum = 0.f;
        for (int st = 0; st <= tw; ++st) {
            f32x16 sacc;
#pragma unroll
            for (int i = 0; i < 16; ++i) sacc[i] = 0.f;
#pragma unroll
            for (int ks = 0; ks < 4; ++ks) { const bf16x8 kf = *(const LAS bf16x8*)(hb + 9216 + (st * 32 + r) * 144 + (16 * ks + 8 * hh) * 2); sacc = MFMA32(kf, qf[ks], sacc); }
            float p[16];
#pragma unroll
            for (int reg = 0; reg < 16; ++reg) { const int s = st * 32 + crow(reg, hh); const float ev = fexp(tb[s] - mh) * sacc[reg]; p[reg] = (s <= t) ? ev : 0.f; dsum += p[reg]; }
#pragma unroll
            for (int k2 = 0; k2 < 2; ++k2) { v4u pw; pw.x = cvtpk(p[8 * k2], p[8 * k2 + 1]); pw.y = cvtpk(p[8 * k2 + 2], p[8 * k2 + 3]); pw.z = cvtpk(p[8 * k2 + 4], p[8 * k2 + 5]); pw.w = cvtpk(p[8 * k2 + 6], p[8 * k2 + 7]);
                const bf16x8 bfg = __builtin_bit_cast(bf16x8, pw);
#pragma unroll
                for (int vt = 0; vt < 2; ++vt) { bf16x8 av; GATHER8(av, hb + 18432, 144, vt * 32 + r, (st * 32 + 16 * k2 + 8 * (j >> 2) + 4 * hh + (j & 3)));
                    accN[vt] = MFMA32(av, bfg, accN[vt]); } }
        }
#pragma unroll
        for (int vt = 0; vt < 2; ++vt)
#pragma unroll
            for (int ks = 0; ks < 4; ++ks) { const f32x4 c0 = cfr[vt][ks][0], c1 = cfr[vt][ks][1];
                v4u cw; cw.x = cvtpk(c0.x, c0.y); cw.y = cvtpk(c0.z, c0.w); cw.z = cvtpk(c1.x, c1.y); cw.w = cvtpk(c1.z, c1.w);
                accI[vt] = MFMA32(__builtin_bit_cast(bf16x8, cw), qf[ks], accI[vt]); }
        float nq = 0.f;
#pragma unroll
        for (int q = 0; q < 4; ++q) { float x[8]; unpack8(*(const LAS v4u*)(hb + t * 144 + (32 * hh + 8 * q) * 2), x);
            nq += (x[0] * nfr[2 * q].x + x[1] * nfr[2 * q].y) + (x[2] * nfr[2 * q].z + x[3] * nfr[2 * q].w) + (x[4] * nfr[2 * q + 1].x + x[5] * nfr[2 * q + 1].y) + (x[6] * nfr[2 * q + 1].z + x[7] * nfr[2 * q + 1].w); }
        nq += __shfl_xor(nq, 32); dsum += __shfl_xor(dsum, 32);
        const float den = dsum + decay * nq, inv = frcp(fmaxf(fabsf(den), fexp(-(bt + mh))));
#pragma unroll
        for (int vt = 0; vt < 2; ++vt)
#pragma unroll
            for (int reg = 0; reg < 16; ++reg) outv[vt][reg] = (accN[vt][reg] + decay * accI[vt][reg]) * inv;
    }
    __syncthreads();
    {
        LAS unsigned char* hb = lds + hd * M3_HB; const int t = sub * 32 + r;
#pragma unroll
        for (int vt = 0; vt < 2; ++vt)
#pragma unroll
            for (int g4 = 0; g4 < 4; ++g4) { v2u w; w.x = cvtpk(outv[vt][4 * g4], outv[vt][4 * g4 + 1]); w.y = cvtpk(outv[vt][4 * g4 + 2], outv[vt][4 * g4 + 3]);
                *(LAS v2u*)(hb + t * 144 + (vt * 32 + 8 * g4 + 4 * hh) * 2) = w; }
    }
    __syncthreads();
    {
#pragma unroll
        for (int i = 0; i < 4; ++i) { const int s = s0 + 16 * i; float hv[8], gv[8];
            unpack8(*(const LAS v4u*)(lds + head * M3_HB + s * 144 + d0 * 2), hv);
            bf16* gp = PROJ + (size_t)(b * SEQ + cm * MCH + s) * NP + C_MO + cc; unpack8(gq[i], gv);
#pragma unroll
            for (int e = 0; e < 8; ++e) hv[e] *= sigm(gv[e]);
            *(v4u*)gp = pack8(hv); }
    }
}

constexpr int ATT_WB = 5120;
DI void att_item(Frame& F, int it) {
    PHASE_IDS;
    bf16* PROJ = (bf16*)(F.ws + WS_PROJ);
    const int qb = it & 511, h = (it >> 9) & 3, b = it >> 11, r = lane & 31, hh = lane >> 5;
    LAS unsigned char* wl = F.lds + F.wave * ATT_WB;
    const size_t rowbase = (size_t)b * SEQ; const int Q0 = qb * 32, qpos = Q0 + r;
    bf16x8 qf[4];
#pragma unroll
    for (int ks = 0; ks < 4; ++ks) qf[ks] = *(const bf16x8*)(PROJ + (rowbase + Q0 + r) * NP + C_SQ + h * 64 + 16 * ks + 8 * hh);
    f32x16 oacc[2];
#pragma unroll
    for (int i = 0; i < 16; ++i) { oacc[0][i] = 0.f; oacc[1][i] = 0.f; }
    float carry = 0.f;
    bf16x8 kfn[4]; v4u vrn[4];
#define ATT_LOAD(KT) do { const int k0_ = (KT) * 32; _Pragma("unroll") for (int ks = 0; ks < 4; ++ks) kfn[ks] = *(const bf16x8*)(PROJ + (rowbase + k0_ + tau(r)) * NP + C_SK + h * 64 + 16 * ks + 8 * hh); \
        _Pragma("unroll") for (int i = 0; i < 4; ++i) vrn[i] = *(const v4u*)(PROJ + (rowbase + k0_ + r) * NP + C_SV + h * 64 + (hh + 2 * i) * 8); } while (0)
    ATT_LOAD(qb);
    for (int kt = qb; kt >= 0; --kt) {
        const int key0 = kt * 32;
        bf16x8 kf[4]; v4u vraw[4];
#pragma unroll
        for (int i = 0; i < 4; ++i) { kf[i] = kfn[i]; vraw[i] = vrn[i]; }
        if (kt > 0) ATT_LOAD(kt - 1);
        f32x16 sacc;
#pragma unroll
        for (int i = 0; i < 16; ++i) sacc[i] = 0.f;
#pragma unroll
        for (int ks = 0; ks < 4; ++ks) sacc = MFMA32(kf[ks], qf[ks], sacc);
#pragma unroll
        for (int i = 0; i < 4; ++i) { const int key = r, d8 = (hh + 2 * i) * 8; const unsigned w[4] = {vraw[i].x, vraw[i].y, vraw[i].z, vraw[i].w};
#pragma unroll
            for (int e = 0; e < 4; ++e) { *(LAS unsigned short*)(wl + (d8 + 2 * e) * 80 + key * 2) = (unsigned short)(w[e] & 0xffffu); *(LAS unsigned short*)(wl + (d8 + 2 * e + 1) * 80 + key * 2) = (unsigned short)(w[e] >> 16); } }
        float bt[16], om[16]; const bool diag = (kt == qb);
#pragma unroll
        for (int reg = 0; reg < 16; ++reg) { const float zz = sacc[reg] * 0.125f, t = fexp(-fabsf(zz)), d = frcp(1.f + t), td = t * d; const bool valid = !diag || (key0 + 16 * hh + reg < qpos), pos = zz >= 0.f;
            bt[reg] = valid ? (pos ? d : td) : 0.f; om[reg] = valid ? (pos ? td : d) : 1.f; }
        float run = 1.f, sufx[16];
#pragma unroll
        for (int reg = 15; reg >= 0; --reg) { sufx[reg] = run; run *= om[reg]; }
        const float tot_o = __shfl_xor(run, 32), basev = fexp(carry) * (hh == 0 ? tot_o : 1.f);
        float pa[16];
#pragma unroll
        for (int reg = 0; reg < 16; ++reg) pa[reg] = bt[reg] * sufx[reg] * basev;
        carry += __logf(run * tot_o);
        asm volatile("s_waitcnt lgkmcnt(0)" ::: "memory");
#pragma unroll
        for (int k2 = 0; k2 < 2; ++k2) { v4u pw; pw.x = cvtpk(pa[8 * k2], pa[8 * k2 + 1]); pw.y = cvtpk(pa[8 * k2 + 2], pa[8 * k2 + 3]); pw.z = cvtpk(pa[8 * k2 + 4], pa[8 * k2 + 5]); pw.w = cvtpk(pa[8 * k2 + 6], pa[8 * k2 + 7]);
            const bf16x8 bfg = __builtin_bit_cast(bf16x8, pw);
#pragma unroll
            for (int dt = 0; dt < 2; ++dt) { const bf16x8 af = *(const LAS bf16x8*)(wl + (dt * 32 + r) * 80 + (16 * hh + 8 * k2) * 2); oacc[dt] = MFMA32(af, bfg, oacc[dt]); } }
        asm volatile("s_waitcnt lgkmcnt(0)" ::: "memory");
        if (__all(carry < -88.f)) break;
    }
#pragma unroll
    for (int dt = 0; dt < 2; ++dt)
#pragma unroll
        for (int g4 = 0; g4 < 4; ++g4) { v2u w; w.x = cvtpk(oacc[dt][4 * g4], oacc[dt][4 * g4 + 1]); w.y = cvtpk(oacc[dt][4 * g4 + 2], oacc[dt][4 * g4 + 3]);
            *(LAS v2u*)(wl + r * 144 + (dt * 32 + 8 * g4 + 4 * hh) * 2) = w; }
    asm volatile("s_waitcnt lgkmcnt(0)" ::: "memory");
#pragma unroll
    for (int i = 0; i < 4; ++i) { const int id = lane + 64 * i, row = id >> 3, c8 = id & 7;
        *(v4u*)(PROJ + (rowbase + Q0 + row) * NP + C_SQ + h * 64 + c8 * 8) = *(const LAS v4u*)(wl + row * 144 + c8 * 16); }
    asm volatile("s_waitcnt lgkmcnt(0)" ::: "memory");
}

DI int OPQ_BX() { int bx = blockIdx.x; asm volatile("" : "+s"(bx)); return bx; }
struct Args { const float* in[20]; float* out; unsigned char* ws; };
constexpr int CW_BAR = 4096, CW_FIN = 10240;
__global__ void __launch_bounds__(NWAVES * 64, 2) trunk_fwd(Args args) {
    extern __shared__ __attribute__((aligned(16))) unsigned char lds_raw[];
    Frame F;
    F.lds = (LAS unsigned char*)lds_raw;
    F.tid0 = threadIdx.x; F.wave = __builtin_amdgcn_readfirstlane(F.tid0 >> 6);
    F.G = gridDim.x; { const int bx = blockIdx.x; F.vcu = (F.G % 8 == 0) ? (bx % 8) * (F.G / 8) + bx / 8 : bx; }
    F.out = args.out; F.ws = args.ws;
    volatile LAS unsigned* MISC = (volatile LAS unsigned*)(F.lds + MISC_OFF);
    for (int u = F.tid0; u < (LDS_BYTES - LDSCTL_OFF) / 4; u += NWAVES * 64) ((LAS unsigned*)(F.lds + LDSCTL_OFF))[u] = 0u;
    __syncthreads();
    if (F.tid0 < 20) *(LAS unsigned long long*)(F.lds + PTR_OFF + 8 * F.tid0) = (unsigned long long)args.in[F.tid0];
    __syncthreads();
    XcdBarrier bar = xcd_barrier_post((unsigned*)(F.ws + WS_CTL) + CW_BAR, MISC + 8);
#define GRID_BAR() xcd_barrier(bar)
    bf16* XN = (bf16*)(F.ws + WS_XN); bf16* PROJ = (bf16*)(F.ws + WS_PROJ); bf16* XR2 = (bf16*)(F.ws + WS_GATES + 32 * MiB);
    const int gw = F.vcu * NWAVES + F.wave, NGW = F.G * NWAVES;

    bf16* XR = (bf16*)F.out;
    phase_weights(F, 0); phase_weights(F, 1);
    __syncthreads();
    phase_w8(F);
    phase_x0(F, inp(F, I_X));
    GRID_BAR();
    for (int l = 0; l < DEPTH; ++l) {
        float* SSQ = (float*)(F.ws + WS_SSQ); unsigned char* wl = F.ws + WS_WL0 + (size_t)l * WS_WLSTRIDE;
        { pg8::Gemm g{XR, (const bf16*)(wl + WO_WIN), M, 2560, D, D, D}; pg8::StaticOrder S; S.init(M, 2560, F.G, OPQ_BX());
          pg8::EpiProj E{PROJ, SSQ  , (float*)(F.ws + WS_IF), (const float*)(inp(F, I_IGB) + l * 4), (const float*)(inp(F, I_FGB) + l * 4)};
          pg8::gemm_phase<pg8::EpiProj, pg8::StaticOrder, pg8::AMapLinear, true, true>(F.lds, g, S, E, pg8::AMapLinear{}); }
        { pg8::Gemm g{(const bf16*)(F.ws + WS_A8), (const bf16*)(F.ws + WS_W8 + (size_t)l * 4 * MiB), M, 3072, 512, 512, 512}; pg8::StaticOrder S; S.init(M, 3072, F.G, OPQ_BX());
          pg8::EpiGates E{(bf16*)(F.ws + WS_GATES), SSQ, (const float*)(F.ws + WS_QSINV), (const float*)(F.ws + WS_W8 + (size_t)l * 4 * MiB + 3 * MiB)};
          pg8::gemm_phase<pg8::EpiGates, pg8::StaticOrder, pg8::AMapLinear, true, true, true>(F.lds, g, S, E, pg8::AMapLinear{}); }
        GRID_BAR();
        if (F.G == BATCH * NLCH) lru_item_sp(F, l, F.vcu / NLCH, F.vcu % NLCH);
        else for (int it = F.vcu; it < BATCH * NLCH; it += F.G) lru_item<false>(F, l, it / NLCH, it % NLCH);
        for (int it = F.vcu; it < BATCH * NMCH; it += F.G) m1_item(F, l, it / NMCH, it % NMCH);
        __syncthreads();
        for (int it = gw; it < BATCH * 4 * (SEQ / 32); it += NGW) att_item(F, it);
        GRID_BAR();
        m2_scan(F);
        if (F.G != BATCH * NLCH) for (int it = F.vcu; it < BATCH * NLCH; it += F.G) lru_item<true>(F, l, it / NLCH, it % NLCH);
        GRID_BAR();
        for (int it = F.vcu; it < BATCH * NMCH; it += F.G) m3_item(F, l, it / NMCH, it % NMCH);
        GRID_BAR();
        { pg8::Gemm g{PROJ, (const bf16*)(wl + WO_WOUT), M, D, 768, NP, 768}; pg8::StaticOrder S; S.init(M, D, F.G, OPQ_BX()); pg8::EpiMerge E{(const bf16*)(F.ws + WS_GATES), XN};
          pg8::gemm_phase<pg8::EpiMerge, pg8::StaticOrder, pg8::AMap3, true, true>(F.lds, g, S, E, pg8::AMap3{}); }
        GRID_BAR();
        { pg8::Gemm g{XN, (const bf16*)(wl + WO_WO), M, D, D, D, D}; pg8::StaticOrder S; S.init(M, D, F.G, OPQ_BX());
          pg8::EpiRes<true> E{(const float*)nullptr, XR, (l + 1 < DEPTH) ? XR : XR2  , SSQ + (size_t)M * 16  , (signed char*)(F.ws + WS_A8), (float*)(F.ws + WS_QSINV), SSQ  };
          pg8::gemm_phase<pg8::EpiRes<true>, pg8::StaticOrder, pg8::AMapLinear, true, true>(F.lds, g, S, E, pg8::AMapLinear{}); }
        GRID_BAR();
        { pg8::Gemm g{(const bf16*)(F.ws + WS_A8), (const bf16*)(wl + WO_W8F), M, 2 * FF, 512, 512, 512}; pg8::StaticOrder S; S.init(M, 2 * FF, F.G, OPQ_BX());
          pg8::EpiSwiglu E{PROJ, SSQ + (size_t)M * 16, (const float*)(F.ws + WS_QSINV), (const float*)(wl + WO_CSF)};
          pg8::gemm_phase<pg8::EpiSwiglu, pg8::StaticOrder, pg8::AMapLinear, true, true, true>(F.lds, g, S, E, pg8::AMapLinear{}); }
        GRID_BAR();
        if (l + 1 < DEPTH) {
          { pg8::Gemm g{PROJ, (const bf16*)(wl + WO_WF2), M, D, FF, FF, FF}; pg8::StaticOrder S; S.init(M, D, F.G, OPQ_BX());
            pg8::EpiRes<true> E{(const float*)nullptr, XR, XR, SSQ  , (signed char*)(F.ws + WS_A8), (float*)(F.ws + WS_QSINV), SSQ + (size_t)M * 16  };
            pg8::gemm_phase<pg8::EpiRes<true>, pg8::StaticOrder, pg8::AMapLinear, true, true>(F.lds, g, S, E, pg8::AMapLinear{}); }
          GRID_BAR();
        } else if (F.G == 256) {
          { pg8::Gemm g{PROJ, (const bf16*)(wl + WO_WF2), M, D, FF, FF, FF}; pg8::StaticOrder S; S.init(M, D, F.G, OPQ_BX());
            pg8::EpiFinal E{XR2, F.out, SSQ, (unsigned*)(F.ws + WS_CTL) + CW_FIN, (const float*)inp(F, I_FNG)};
            pg8::gemm_phase<pg8::EpiFinal, pg8::StaticOrder, pg8::AMapLinear, true, true>(F.lds, g, S, E, pg8::AMapLinear{}); }
        } else {
          { pg8::Gemm g{PROJ, (const bf16*)(wl + WO_WF2), M, D, FF, FF, FF}; pg8::StaticOrder S; S.init(M, D, F.G, OPQ_BX());
            pg8::EpiRes<true> E{(const float*)nullptr, XR2, XN, SSQ, (signed char*)nullptr, (float*)(F.ws + WS_QSINV), SSQ + (size_t)M * 16};
            pg8::gemm_phase<pg8::EpiRes<true>, pg8::StaticOrder, pg8::AMapLinear, true, true>(F.lds, g, S, E, pg8::AMapLinear{}); }
          GRID_BAR();
          phase_final_norm(F, F.out, inp(F, I_FNG));
        }
    }
}

extern "C" void kernel_launch(void* const* d_in, const int* in_sizes, int n_in, void* d_out, int out_size, void* d_ws, size_t ws_size, hipStream_t stream) {
    static int grid = 0;
    if (grid == 0) {
        if (n_in != 20 || in_sizes[0] != M * D || out_size != M * D || ws_size < WS_END) { fprintf(stderr, "kernel_launch: unexpected shapes (n_in %d, in0 %d, out %d, ws %zu)\n", n_in, n_in > 0 ? in_sizes[0] : -1, out_size, ws_size); grid = -1; return; }
        int dev = 0, cus = 0, per_cu = 0;
        if (hipGetDevice(&dev) != hipSuccess || hipDeviceGetAttribute(&cus, hipDeviceAttributeMultiprocessorCount, dev) != hipSuccess) { grid = -1; return; }
        if (hipFuncSetAttribute((const void*)trunk_fwd, hipFuncAttributeMaxDynamicSharedMemorySize, LDS_BYTES) != hipSuccess) { fprintf(stderr, "kernel_launch: hipFuncSetAttribute failed\n"); grid = -1; return; }
        if (hipOccupancyMaxActiveBlocksPerMultiprocessor(&per_cu, (const void*)trunk_fwd, NWAVES * 64, LDS_BYTES) != hipSuccess || per_cu < 1)
            fprintf(stderr, "kernel_launch: note: occupancy query reports %d workgroups per CU\n", per_cu);
        (void)hipGetLastError();
        if (cus != 256) { fprintf(stderr, "kernel_launch: built for a 256-CU device (got %d)\n", cus); grid = -1; return; }
        grid = cus;
    }
    if (grid < 0) return;
    if (hipMemsetAsync((char*)d_ws + WS_CTL, 0, CTL_ZERO_BYTES, stream) != hipSuccess) return;
    Args a{};
    for (int i = 0; i < 20; ++i) a.in[i] = (const float*)d_in[i];
    a.out = (float*)d_out; a.ws = (unsigned char*)d_ws;
    hipLaunchKernelGGL(trunk_fwd, dim3(grid), dim3(NWAVES * 64), LDS_BYTES, stream, a);
}
```

```cpp
#include <hip/hip_runtime.h>
#include <cstdio>
#include <cstdint>

#define DI __device__ __forceinline__
#define GAS __attribute__((address_space(1)))
#define LAS __attribute__((address_space(3)))
typedef unsigned short bf16;
typedef unsigned v4u __attribute__((ext_vector_type(4)));
typedef unsigned v2u __attribute__((ext_vector_type(2)));
typedef float f32x2 __attribute__((ext_vector_type(2)));
typedef float f32x4 __attribute__((ext_vector_type(4)));
typedef float f32x16 __attribute__((ext_vector_type(16)));
typedef short bf16x8 __attribute__((ext_vector_type(8)));
typedef short s16x4 __attribute__((ext_vector_type(4)));
typedef __bf16 bf16x2_t __attribute__((ext_vector_type(2)));

constexpr int BATCH = 2, SEQ = 16384, D = 1024, M = BATCH * SEQ, DEPTH = 2;
constexpr int FF = 2816;
constexpr int NP = 2304;
constexpr int C_LX = 0, C_LG = 256, C_MQ = 512, C_MK = 768, C_MV = 1024, C_MO = 1280, C_SQ = 1536, C_SK = 1792, C_SV = 2048, C_GA = 2304;
constexpr int IN_COLS = 5384;
constexpr float EPS = 1e-6f;
constexpr int LCH = 128, NLCH = SEQ / LCH;
constexpr int MCH = 64, NMCH = SEQ / MCH;

constexpr size_t MiB = 1u << 20;
constexpr size_t WS_CTL = 0, CTL_ZERO_BYTES = 64 * 1024;
constexpr size_t WS_SSQ = 503 * MiB;
constexpr size_t WS_WL0 = 2 * MiB, WS_WLSTRIDE = 33 * MiB;
constexpr size_t WO_WIN = 0;
constexpr size_t WO_WOUT = 11 * MiB;
constexpr size_t WO_WO = 13 * MiB;
constexpr size_t WO_WF1 = 15 * MiB;
constexpr size_t WO_WF2 = 26 * MiB;
constexpr size_t WO_LRUW = 32 * MiB;
constexpr size_t WS_LSUM = 68 * MiB;
constexpr size_t WS_MSC = 68 * MiB + 512 * 1024;
constexpr size_t WS_IF = 69 * MiB;
constexpr size_t WS_MST = 70 * MiB;
constexpr size_t WS_MSN = 102 * MiB;
constexpr size_t WS_XN = 103 * MiB;
constexpr size_t WS_PROJ = 167 * MiB;
constexpr size_t WS_GATES = WS_PROJ + 144 * MiB;
constexpr size_t WO_W8F = WO_WF1, WO_CSF = WO_WF1 + 6 * MiB;
constexpr float QCLIP = 127.f / 4.5f;
constexpr size_t WS_A8 = WS_PROJ + 248 * MiB;
constexpr size_t WS_W8 = WS_PROJ + 284 * MiB;
constexpr size_t WS_QSINV = WS_PROJ + 296 * MiB;
constexpr size_t WS_END = 507 * MiB;

constexpr int RING_BYTES = 131072;
constexpr int LDS_BYTES = 147456;
constexpr int LDSCTL_OFF = LDS_BYTES - 512, MISC_OFF = LDSCTL_OFF + 320;
constexpr int CFTAB_OFF = 131072;
constexpr int RSTAB_OFF = 135680;
static_assert(RSTAB_OFF >= RING_BYTES && RSTAB_OFF + 11 * 1024 <= LDSCTL_OFF, "LDS map");

DI unsigned cvtpk(float lo, float hi) { f32x2 v = {lo, hi}; bf16x2_t b = __builtin_convertvector(v, bf16x2_t); return __builtin_bit_cast(unsigned, b); }
DI float bf2f(unsigned short b) { return __uint_as_float(((unsigned)b) << 16); }
DI float bflo(unsigned w) { return __uint_as_float(w << 16); }
DI float bfhi(unsigned w) { return __uint_as_float(w & 0xffff0000u); }
DI float fexp(float x) { return __expf(x); }
DI float frcp(float x) { return __builtin_amdgcn_rcpf(x); }
DI float sigm(float x) { return frcp(1.f + fexp(-x)); }
DI float softplus(float z) { return fmaxf(z, 0.f) + __logf(1.f + fexp(-fabsf(z))); }
DI float siluf(float x) { return x * sigm(x); }
DI float gelu_tanh(float x) { const float u = 0.7978845608028654f * (x + 0.044715f * x * x * x); const float t = 1.f - 2.f * frcp(fexp(2.f * u) + 1.f); return 0.5f * x * (1.f + t); }
#define MFMA32(a, b, c) __builtin_amdgcn_mfma_f32_32x32x16_bf16((a), (b), (c), 0, 0, 0)
DI int crow(int reg, int h) { return (reg & 3) + 8 * (reg >> 2) + 4 * h; }
DI int tau(int m) { return (((m >> 2) & 1) << 4) | ((m >> 3) << 2) | (m & 3); }

namespace pg8 {
#define PG8_LAS __attribute__((address_space(3)))
typedef unsigned short bf16_t;
typedef unsigned u32x4 __attribute__((ext_vector_type(4)));
typedef int i32x4 __attribute__((ext_vector_type(4)));
typedef unsigned u32x2 __attribute__((ext_vector_type(2)));
constexpr int BM = 256, BK = 64, HALF = 128, HTB = HALF * BK * 2, STAGE_BYTES = 8 * HTB, NXCD = 8, WGM = 8;
__host__ __device__ __forceinline__ int lds_byte(int r, int c) { const int st = (r >> 4) * 2 + (c >> 5), rr = r & 15, cc = c & 31, ob = rr * 64 + cc * 2; return st * 1024 + (ob ^ (((ob >> 9) & 1) << 5)); }
__host__ __device__ __forceinline__ void stage_rc(int b, int& R, int& C) { const int st = b / 1024, sb = b % 1024, swz = sb ^ (((sb >> 9) & 1) << 5); R = (st >> 1) * 16 + swz / 64; C = (st & 1) * 32 + (swz % 64) / 2; }
__host__ __device__ __forceinline__ int perm32(int rho) { const int n = rho >> 4, i = rho & 15; return 8 * (i >> 2) + 4 * n + (i & 3); }

struct Unit { int pm, pn; };
struct Gemm { const bf16_t* A; const bf16_t* Bt; int M, N, K, lda, ldb; };
struct StaticOrder {
    int nM, nN, nwg, G, c;
    __host__ __device__ void init(int M_, int N_, int G_, int c_) { nM = M_ / BM; nN = N_ / BM; nwg = nM * nN; G = G_; c = c_; }
    __host__ __device__ bool next(int i, Unit& u) const {
        const long L = (long)i * G + c; if (L >= nwg) return false;
        int wgid = (int)L; { const int q = nwg / NXCD, r = nwg % NXCD, xcd = wgid % NXCD, off = wgid / NXCD; wgid = (xcd < r ? xcd * (q + 1) : r * (q + 1) + (xcd - r) * q) + off; }
        const int nig = WGM * nN, gid = wgid / nig, fm = gid * WGM, gsz = (nM - fm) < WGM ? (nM - fm) : WGM;
        u.pm = fm + ((wgid % nig) % gsz); u.pn = (wgid % nig) / gsz; return true;
    }
};
__device__ __forceinline__ float rstd_of(const float* slots) {
    const f32x4 a = *(const f32x4*)slots, b = *(const f32x4*)(slots + 4), c = *(const f32x4*)(slots + 8), d = *(const f32x4*)(slots + 12);
    const float s = ((a.x + a.y) + (a.z + a.w)) + ((b.x + b.y) + (b.z + b.w)) + (((c.x + c.y) + (c.z + c.w)) + ((d.x + d.y) + (d.z + d.w)));
    return 1.f / sqrtf(s * (1.f / D) + EPS); }
struct AMapLinear { __device__ __forceinline__ size_t operator()(int t) const { return (size_t)t * (BK * 2); } };
struct AMap3 { __device__ __forceinline__ size_t operator()(int t) const { const int s = t >> 2; return (size_t)((256 + 1024 * s - 768 * (s >> 1)) * 2 + (t & 3) * (BK * 2)); } };

template <class Epi, class Sched, class AMap, bool ALIGN_EPI = false, bool SP2 = false, bool I8 = false>
__device__ __forceinline__ void gemm_phase(PG8_LAS unsigned char* lds, const Gemm g, const Sched& S, const Epi& E, const AMap& AM) {
    int tid_ = threadIdx.x; asm volatile("" : "+v"(tid_));
    const int tid = tid_, wid = __builtin_amdgcn_readfirstlane(tid >> 6), lane = tid & 63, wr = wid >> 2, wc = wid & 3, fr = lane & 15, fq = lane >> 4;
    const int K = g.K, nt = K / BK;
    unsigned voffA[2], voffB[2];
#pragma unroll
    for (int i = 0; i < 2; ++i) { int R, C; stage_rc(tid * 16 + i * 8192, R, C); const int Rb = Epi::PERM ? ((R & ~31) + perm32(R & 31)) : R;
        voffA[i] = (unsigned)(R * g.lda + C) * 2u; voffB[i] = (unsigned)(Rb * g.ldb + C) * 2u; }
    const size_t kstep = (size_t)(BK * 2);
    const size_t hstepA = (size_t)HALF * g.lda * 2, hstepB = (size_t)HALF * g.ldb * 2;
    const size_t tstepA = 2 * hstepA, tstepB = 2 * hstepB;
    const unsigned ldsw = (unsigned)wid * 1024u;
    const int aoff = lds_byte(wr * 64 + fr, fq * 8), boff = lds_byte(wc * 32 + fr, fq * 8);
#define PG8_SA(b, h) (((b) * 2 + (h)) * HTB)
#define PG8_SB(b, h) ((4 + (b) * 2 + (h)) * HTB)
#define PG8_STAGE(bufoff, gbase, voff) do { _Pragma("unroll") for (int _i = 0; _i < 2; ++_i) \
        __builtin_amdgcn_global_load_lds((const unsigned*)((const char*)(gbase) + (voff)[_i]), (PG8_LAS unsigned*)(lds + (bufoff) + ldsw + _i * 8192), 16, 0, 0); } while (0)
#define PG8_LDA(dst, b, h) do { _Pragma("unroll") for (int m = 0; m < 4; ++m) _Pragma("unroll") for (int k = 0; k < 2; ++k) dst[m][k] = *(const PG8_LAS bf16x8*)(lds + PG8_SA(b, h) + aoff + m * 2048 + k * 1024); } while (0)
#define PG8_LDB(dst, b, h) do { _Pragma("unroll") for (int n = 0; n < 2; ++n) _Pragma("unroll") for (int k = 0; k < 2; ++k) dst[n][k] = *(const PG8_LAS bf16x8*)(lds + PG8_SB(b, h) + boff + n * 2048 + k * 1024); } while (0)
#define PG8_MMA(ai, bj, At, Bt) do { __builtin_amdgcn_s_setprio(1); _Pragma("unroll") for (int m = 0; m < 4; ++m) _Pragma("unroll") for (int n = 0; n < 2; ++n) _Pragma("unroll") for (int k = 0; k < 2; ++k) { \
        if constexpr (I8) acc[ai][bj][m][n] = __builtin_bit_cast(f32x4, __builtin_amdgcn_mfma_i32_16x16x64_i8(__builtin_bit_cast(i32x4, Bt[n][k]), __builtin_bit_cast(i32x4, At[m][k]), __builtin_bit_cast(i32x4, acc[ai][bj][m][n]), 0, 0, 0)); \
        else acc[ai][bj][m][n] = __builtin_amdgcn_mfma_f32_16x16x32_bf16(Bt[n][k], At[m][k], acc[ai][bj][m][n], 0, 0, 0); } __builtin_amdgcn_s_setprio(0); } while (0)
#define PG8_WAIT_V(n) asm volatile("s_waitcnt vmcnt(" #n ")" ::: "memory")
#define PG8_WAIT_L(n) asm volatile("s_waitcnt lgkmcnt(" #n ")" ::: "memory")
#define PG8_BAR __builtin_amdgcn_s_barrier()
#define PG8_SCHED __builtin_amdgcn_sched_barrier(0)
    Unit cur, nxt; int ui = 0, ts = 0;
    if (!S.next(0, cur)) return;
    f32x4 acc[2][2][4][2];
#pragma unroll
    for (int a = 0; a < 2; ++a)
#pragma unroll
        for (int b = 0; b < 2; ++b)
#pragma unroll
            for (int m = 0; m < 4; ++m)
#pragma unroll
                for (int n = 0; n < 2; ++n) acc[a][b][m][n] = (f32x4){0.f, 0.f, 0.f, 0.f};
    bf16x8 At[4][2], B0[2][2], B1[2][2];
    const char* cA = (const char*)g.A + (size_t)cur.pm * tstepA; const char* cB = (const char*)g.Bt + (size_t)cur.pn * tstepB;
    if constexpr (SP2) {
        PG8_STAGE(PG8_SB(0, 0), cB, voffB); PG8_STAGE(PG8_SB(0, 1), cB + hstepB, voffB); PG8_STAGE(PG8_SA(0, 0), cA + AM(0), voffA); PG8_STAGE(PG8_SA(0, 1), cA + AM(0) + hstepA, voffA);
        if constexpr (Epi::HAS_PREP) { int lastpm = -1, slot = -1; for (int i = 0; S.next(i, nxt); ++i) if (nxt.pm != lastpm) { lastpm = nxt.pm; ++slot; E.prep(lds, slot, nxt, tid); } asm volatile("s_waitcnt lgkmcnt(0)" ::: "memory"); }
        if (wr == 1) PG8_BAR;
        PG8_WAIT_V(2); PG8_BAR;
        PG8_STAGE(PG8_SB(1, 0), cB + kstep, voffB); PG8_STAGE(PG8_SA(1, 0), cA + AM(1), voffA); PG8_STAGE(PG8_SB(1, 1), cB + hstepB + kstep, voffB);
        PG8_WAIT_V(6); PG8_BAR;
    } else {
        if constexpr (Epi::HAS_PREP) { int lastpm = -1, slot = -1; for (int i = 0; S.next(i, nxt); ++i) if (nxt.pm != lastpm) { lastpm = nxt.pm; ++slot; E.prep(lds, slot, nxt, tid); } asm volatile("s_waitcnt lgkmcnt(0)" ::: "memory"); }
        PG8_STAGE(PG8_SB(0, 0), cB, voffB); PG8_STAGE(PG8_SA(0, 0), cA + AM(0), voffA); PG8_STAGE(PG8_SB(0, 1), cB + hstepB, voffB); PG8_STAGE(PG8_SA(0, 1), cA + AM(0) + hstepA, voffA);
        if (wr == 1) PG8_BAR;
        PG8_WAIT_V(4); PG8_BAR;
        PG8_STAGE(PG8_SB(1, 0), cB + kstep, voffB); PG8_STAGE(PG8_SA(1, 0), cA + AM(1), voffA); PG8_STAGE(PG8_SB(1, 1), cB + hstepB + kstep, voffB);
        PG8_WAIT_V(6); PG8_BAR;
    }
    for (;;) {
        const bool has_next = S.next(ui + 1, nxt);
        if constexpr (Epi::HAS_COLTAB) { if (wid < 4) __builtin_amdgcn_global_load_lds((const unsigned*)(E.cs + cur.pn * BM + tid), (PG8_LAS unsigned*)(lds + CFTAB_OFF + (ui & 1) * 1024 + wid * 256), 4, 0, 0); }
        const char* nA = has_next ? (const char*)g.A + (size_t)nxt.pm * tstepA : cA; const char* nB = has_next ? (const char*)g.Bt + (size_t)nxt.pn * tstepB : cB;
        for (int t = 0; t < nt; t += 2) {
            const bool last = (t == nt - 2);
            const char* a1 = cA + AM(t + 1);
            const char* a2 = last ? nA + AM(0) : cA + AM(t + 2); const char* b2 = last ? nB : cB + (size_t)(t + 2) * kstep;
            const char* a3 = last ? nA + AM(1) : cA + AM(t + 3); const char* b3 = b2 + kstep;
            if constexpr (SP2) {
            PG8_LDB(B0, 0, 0); PG8_LDB(B1, 0, 1); PG8_SCHED; PG8_LDA(At, 0, 0); PG8_STAGE(PG8_SA(1, 1), a1 + hstepA, voffA);
            PG8_WAIT_V(8); PG8_WAIT_L(0); PG8_BAR; PG8_MMA(0, 0, At, B0); PG8_MMA(0, 1, At, B1); PG8_BAR; PG8_SCHED;
            PG8_LDA(At, 0, 1); PG8_STAGE(PG8_SB(0, 0), b2, voffB); PG8_STAGE(PG8_SB(0, 1), b2 + hstepB, voffB); PG8_STAGE(PG8_SA(0, 0), a2, voffA);
            PG8_WAIT_V(8); PG8_WAIT_L(0); PG8_BAR; PG8_MMA(1, 0, At, B0); PG8_MMA(1, 1, At, B1); PG8_BAR; PG8_SCHED;
            PG8_LDB(B0, 1, 0); PG8_LDB(B1, 1, 1); PG8_SCHED; PG8_LDA(At, 1, 0); PG8_STAGE(PG8_SA(0, 1), a2 + hstepA, voffA);
            PG8_WAIT_V(8); PG8_WAIT_L(0); PG8_BAR; PG8_MMA(0, 0, At, B0); PG8_MMA(0, 1, At, B1); PG8_BAR; PG8_SCHED;
            PG8_LDA(At, 1, 1); PG8_STAGE(PG8_SB(1, 0), b3, voffB); PG8_STAGE(PG8_SB(1, 1), b3 + hstepB, voffB); PG8_STAGE(PG8_SA(1, 0), a3, voffA);
            PG8_WAIT_V(8); PG8_WAIT_L(0); PG8_BAR; PG8_MMA(1, 0, At, B0); PG8_MMA(1, 1, At, B1); PG8_BAR; PG8_SCHED;
            } else {
            PG8_LDB(B0, 0, 0); PG8_SCHED; PG8_LDA(At, 0, 0); PG8_STAGE(PG8_SA(1, 1), a1 + hstepA, voffA);
            PG8_WAIT_L(8); PG8_BAR; PG8_WAIT_L(0); PG8_MMA(0, 0, At, B0); PG8_BAR; PG8_SCHED;
            PG8_LDB(B1, 0, 1); PG8_STAGE(PG8_SB(0, 0), b2, voffB);
            PG8_BAR; PG8_WAIT_L(0); PG8_MMA(0, 1, At, B1); PG8_BAR;
            PG8_LDA(At, 0, 1); PG8_STAGE(PG8_SA(0, 0), a2, voffA);
            PG8_BAR; PG8_WAIT_L(0); PG8_MMA(1, 0, At, B0); PG8_BAR; PG8_SCHED;
            PG8_STAGE(PG8_SB(0, 1), b2 + hstepB, voffB);
            PG8_WAIT_V(6); PG8_BAR; PG8_MMA(1, 1, At, B1); PG8_BAR;
            PG8_LDB(B0, 1, 0); PG8_SCHED; PG8_LDA(At, 1, 0); PG8_STAGE(PG8_SA(0, 1), a2 + hstepA, voffA);
            PG8_WAIT_L(8); PG8_BAR; PG8_WAIT_L(0); PG8_MMA(0, 0, At, B0); PG8_BAR; PG8_SCHED;
            PG8_LDB(B1, 1, 1); PG8_STAGE(PG8_SB(1, 0), b3, voffB);
            PG8_BAR; PG8_WAIT_L(0); PG8_MMA(0, 1, At, B1); PG8_BAR;
            PG8_LDA(At, 1, 1); PG8_STAGE(PG8_SA(1, 0), a3, voffA);
            PG8_BAR; PG8_WAIT_L(0); PG8_MMA(1, 0, At, B0); PG8_BAR; PG8_SCHED;
            PG8_STAGE(PG8_SB(1, 1), b3 + hstepB, voffB);
            PG8_WAIT_V(6); PG8_BAR; PG8_MMA(1, 1, At, B1); PG8_BAR;
            }
            if constexpr (Epi::HAS_MID) { if (!last && ((t + 2) & 3) == 0) E.mid(acc, cur, (t + 2) >> 2, wr, wc, fr, fq); }
        }
        if constexpr (ALIGN_EPI) { if (wr == 0) PG8_BAR; }
        E(acc, cur, ui | (ts << 8), lds, wr, wc, fr, fq);
        if (!has_next) break;
#pragma unroll
        for (int a = 0; a < 2; ++a)
#pragma unroll
            for (int b = 0; b < 2; ++b)
#pragma unroll
                for (int m = 0; m < 4; ++m)
#pragma unroll
                    for (int n = 0; n < 2; ++n) acc[a][b][m][n] = (f32x4){0.f, 0.f, 0.f, 0.f};
        ts += (nxt.pm != cur.pm) ? 1 : 0; cur = nxt; cA = nA; cB = nB; ++ui;
        if constexpr (ALIGN_EPI) { if (wr == 1) PG8_BAR; }
    }
    PG8_WAIT_V(0);
    if constexpr (!ALIGN_EPI) { if (wr == 0) PG8_BAR; }
    PG8_BAR;
#undef PG8_SA
#undef PG8_SB
#undef PG8_STAGE
#undef PG8_LDA
#undef PG8_LDB
#undef PG8_MMA
#undef PG8_WAIT_V
#undef PG8_WAIT_L
#undef PG8_BAR
#undef PG8_SCHED
}

struct EpiProj {
    static constexpr bool PERM = true, HAS_MID = false, HAS_PREP = true, HAS_COLTAB = false;
    bf16_t* O; const float* ssq; float* IFB; const float* igb; const float* fgb;
    __device__ __forceinline__ void prep(PG8_LAS unsigned char* lds, int i, const Unit& u, int tid) const { if (tid < 256) *(PG8_LAS float*)(lds + RSTAB_OFF + (i * 256 + tid) * 4) = rstd_of(ssq + (size_t)(u.pm * BM + tid) * 16); }
    __device__ __forceinline__ void operator()(const f32x4 (&acc)[2][2][4][2], const Unit& u, int ui, PG8_LAS unsigned char* lds, int wr, int wc, int fr, int fq) const {
        const int row0 = u.pm * BM + wr * 64 + fr, col0 = u.pn * BM + wc * 32 + 8 * fq;
        float rs[2][4];
#pragma unroll
        for (int ai = 0; ai < 2; ++ai)
#pragma unroll
            for (int m = 0; m < 4; ++m) rs[ai][m] = *(const PG8_LAS float*)(lds + RSTAB_OFF + ((ui >> 8) * 256 + wr * 64 + fr + ai * HALF + m * 16) * 4);
        if (u.pn < 9) {
#pragma unroll
        for (int ai = 0; ai < 2; ++ai)
#pragma unroll
            for (int m = 0; m < 4; ++m) { bf16_t* rowp = O + (size_t)(row0 + ai * HALF + m * 16) * NP + col0; const float r = rs[ai][m];
#pragma unroll
                for (int bj = 0; bj < 2; ++bj) { const f32x4 v0 = acc[ai][bj][m][0] * r, v1 = acc[ai][bj][m][1] * r;
                    u32x4 w; w.x = cvtpk(v0[0], v0[1]); w.y = cvtpk(v0[2], v0[3]); w.z = cvtpk(v1[0], v1[1]); w.w = cvtpk(v1[2], v1[3]);
                    *(u32x4*)(rowp + bj * HALF) = w; } }
        } else if (wc == 0 && fq == 0) {
            const f32x4 bi = *(const f32x4*)igb, bf = *(const f32x4*)fgb;
#pragma unroll
            for (int ai = 0; ai < 2; ++ai)
#pragma unroll
                for (int m = 0; m < 4; ++m) { float* p = IFB + (size_t)(row0 + ai * HALF + m * 16) * 8; const float r = rs[ai][m];
                    const f32x4 vi = acc[ai][0][m][0] * r + bi; f32x4 vf = acc[ai][0][m][1] * r + bf;
#pragma unroll
                    for (int j = 0; j < 4; ++j) vf[j] = -softplus(-vf[j]);
                    *(f32x4*)p = vi; *(f32x4*)(p + 4) = vf; }
        }
    }
};
struct EpiGates {
    static constexpr bool PERM = true, HAS_MID = false, HAS_PREP = true, HAS_COLTAB = true;
    bf16_t* GT; const float* ssq; const float* qsinv; const float* cs;
    __device__ __forceinline__ void prep(PG8_LAS unsigned char* lds, int i, const Unit& u, int tid) const { if (tid < 256) { const size_t row = (size_t)(u.pm * BM + tid); *(PG8_LAS float*)(lds + RSTAB_OFF + (i * 256 + tid) * 4) = rstd_of(ssq + row * 16) * qsinv[row] * -1.4426950408889634f; } }
    __device__ __forceinline__ void operator()(const f32x4 (&acc)[2][2][4][2], const Unit& u, int ui, PG8_LAS unsigned char* lds, int wr, int wc, int fr, int fq) const {
        const int col0 = u.pn * BM + wc * 32 + 8 * fq;
        f32x4 cf[2][2];
#pragma unroll
        for (int bj = 0; bj < 2; ++bj)
#pragma unroll
            for (int n = 0; n < 2; ++n) cf[bj][n] = *(const PG8_LAS f32x4*)(lds + CFTAB_OFF + (ui & 1) * 1024 + (wc * 32 + 8 * fq + bj * HALF + 4 * n) * 4);
        u32x4* tp = (u32x4*)GT + ((size_t)(u.pm * 12 + u.pn) * 8) * 512 + ((wr * 4 + wc) * 64 + fq * 16 + fr);
#pragma unroll
        for (int ai = 0; ai < 2; ++ai)
#pragma unroll
            for (int m = 0; m < 4; ++m) { const float r = *(const PG8_LAS float*)(lds + RSTAB_OFF + ((ui >> 8) * 256 + wr * 64 + fr + ai * HALF + m * 16) * 4); unsigned q[4];
#pragma unroll
                for (int bj = 0; bj < 2; ++bj)
#pragma unroll
                    for (int n = 0; n < 2; ++n) { const i32x4 ia = __builtin_bit_cast(i32x4, acc[ai][bj][m][n]); const f32x4 cr = cf[bj][n] * r; unsigned w = 0u;
#define Q8(x) __builtin_amdgcn_rcpf(__builtin_fmaf(__builtin_amdgcn_exp2f(x), 1.f / 255.f, 1.f / 255.f))
                        w = __builtin_amdgcn_cvt_pk_u8_f32(Q8((float)ia[0] * cr[0]), 0, w); w = __builtin_amdgcn_cvt_pk_u8_f32(Q8((float)ia[1] * cr[1]), 1, w); w = __builtin_amdgcn_cvt_pk_u8_f32(Q8((float)ia[2] * cr[2]), 2, w); w = __builtin_amdgcn_cvt_pk_u8_f32(Q8((float)ia[3] * cr[3]), 3, w); q[bj * 2 + n] = w; }
#undef Q8
                u32x4 w4; w4.x = q[0]; w4.y = q[1]; w4.z = q[2]; w4.w = q[3];
                tp[(size_t)(ai * 4 + m) * 512] = w4; }
    }
};
struct EpiMerge {
    static constexpr bool PERM = true, HAS_MID = true, HAS_PREP = false, HAS_COLTAB = false;
    const bf16_t* GT; bf16_t* O;
    __device__ __forceinline__ static void ld8(const bf16_t* p, float (&g)[8]) { const u32x4 w = *(const u32x4*)p;
        g[0] = bflo(w.x); g[1] = bfhi(w.x); g[2] = bflo(w.y); g[3] = bfhi(w.y); g[4] = bflo(w.z); g[5] = bfhi(w.z); g[6] = bflo(w.w); g[7] = bfhi(w.w);
#pragma unroll
        for (int j = 0; j < 8; ++j) g[j] = fmaxf(g[j], 1e-20f); }
    __device__ __forceinline__ static void raw4(unsigned w, float (&g)[8], int o) {
        g[o + 0] = fmaxf((float)(w & 0xffu), 0.5f); g[o + 1] = fmaxf((float)((w >> 8) & 0xffu), 0.5f); g[o + 2] = fmaxf((float)((w >> 16) & 0xffu), 0.5f); g[o + 3] = fmaxf((float)(w >> 24), 0.5f); }
    __device__ __forceinline__ static void up4(unsigned w, float (&g)[8], int o) {
        g[o + 0] = fmaxf((float)(w & 0xffu), 0.5f) * (1.f / 255.f); g[o + 1] = fmaxf((float)((w >> 8) & 0xffu), 0.5f) * (1.f / 255.f);
        g[o + 2] = fmaxf((float)((w >> 16) & 0xffu), 0.5f) * (1.f / 255.f); g[o + 3] = fmaxf((float)(w >> 24), 0.5f) * (1.f / 255.f); }
    __device__ __forceinline__ void mid(f32x4 (&acc)[2][2][4][2], const Unit& u, int nb  , int wr, int wc, int fr, int fq) const {
        int lid = (wr * 4 + wc) * 64 + fq * 16 + fr;
        asm volatile("" : "+v"(lid));
        const u32x4* tp = (const u32x4*)GT + ((size_t)(u.pm * 12 + (nb - 1) * 4 + u.pn) * 8) * 512 + lid; const u32x4* tn = tp + (size_t)4 * 8 * 512;
        u32x4 wp[2][4], wn[2][4];
#pragma unroll
        for (int ai = 0; ai < 2; ++ai)
#pragma unroll
            for (int m = 0; m < 4; ++m) { const size_t o = (size_t)(ai * 4 + m) * 512; wp[ai][m] = tp[o]; wn[ai][m] = tn[o]; }
#pragma unroll
        for (int ai = 0; ai < 2; ++ai)
#pragma unroll
            for (int m = 0; m < 4; ++m) { float gp[8], gn[8];
                raw4(wp[ai][m].x, gp, 0); raw4(wp[ai][m].y, gp, 4); raw4(wn[ai][m].x, gn, 0); raw4(wn[ai][m].y, gn, 4);
#pragma unroll
                for (int j = 0; j < 4; ++j) { acc[ai][0][m][0][j] *= gp[j] * frcp(gn[j]); acc[ai][0][m][1][j] *= gp[4 + j] * frcp(gn[4 + j]); }
                raw4(wp[ai][m].z, gp, 0); raw4(wp[ai][m].w, gp, 4); raw4(wn[ai][m].z, gn, 0); raw4(wn[ai][m].w, gn, 4);
#pragma unroll
                for (int j = 0; j < 4; ++j) { acc[ai][1][m][0][j] *= gp[j] * frcp(gn[j]); acc[ai][1][m][1][j] *= gp[4 + j] * frcp(gn[4 + j]); } }
    }
    __device__ __forceinline__ void operator()(const f32x4 (&acc)[2][2][4][2], const Unit& u, int ui, PG8_LAS unsigned char* lds, int wr, int wc, int fr, int fq) const {
        const int row0 = u.pm * BM + wr * 64 + fr, col0 = u.pn * BM + wc * 32 + 8 * fq;
        const u32x4* tg = (const u32x4*)GT + ((size_t)(u.pm * 12 + 2 * 4 + u.pn) * 8) * 512 + ((wr * 4 + wc) * 64 + fq * 16 + fr);
        u32x4 wg[2][4];
#pragma unroll
        for (int ai = 0; ai < 2; ++ai)
#pragma unroll
            for (int m = 0; m < 4; ++m) wg[ai][m] = tg[(size_t)(ai * 4 + m) * 512];
#pragma unroll
        for (int ai = 0; ai < 2; ++ai)
#pragma unroll
            for (int m = 0; m < 4; ++m) { const size_t r = (size_t)(row0 + ai * HALF + m * 16);
#pragma unroll
                for (int bj = 0; bj < 2; ++bj) { float gl[8]; up4(bj ? wg[ai][m].z : wg[ai][m].x, gl, 0); up4(bj ? wg[ai][m].w : wg[ai][m].y, gl, 4);
                    const f32x4 v0 = acc[ai][bj][m][0], v1 = acc[ai][bj][m][1];
                    u32x4 w; w.x = cvtpk(v0[0] * gl[0], v0[1] * gl[1]); w.y = cvtpk(v0[2] * gl[2], v0[3] * gl[3]); w.z = cvtpk(v1[0] * gl[4], v1[1] * gl[5]); w.w = cvtpk(v1[2] * gl[6], v1[3] * gl[7]);
                    *(u32x4*)(O + r * D + col0 + bj * HALF) = w; } }
    }
};
template <bool A8OUT> struct EpiRes {
    static constexpr bool PERM = true, HAS_MID = false, HAS_PREP = A8OUT, HAS_COLTAB = false;
    const float* basef; const bf16_t* xr; bf16_t* xout; float* ssq; signed char* a8; float* qsinv; const float* ssqp;
    __device__ __forceinline__ void prep(PG8_LAS unsigned char* lds, int i, const Unit& u, int tid) const { if (a8 && tid < 256) *(PG8_LAS float*)(lds + RSTAB_OFF + (i * 256 + tid) * 4) = QCLIP * rstd_of(ssqp + (size_t)(u.pm * BM + tid) * 16); }
    __device__ __forceinline__ static void q8store(const f32x4& x0, const f32x4& x1, float qs, signed char* p) {
        constexpr float MAG = 12582912.f; unsigned t0[4], t1[4];
#pragma unroll
        for (int j = 0; j < 4; ++j) { t0[j] = __float_as_uint(__builtin_amdgcn_fmed3f(__builtin_fmaf(x0[j], qs, MAG), MAG - 127.f, MAG + 127.f)); t1[j] = __float_as_uint(__builtin_amdgcn_fmed3f(__builtin_fmaf(x1[j], qs, MAG), MAG - 127.f, MAG + 127.f)); }
        const unsigned lo = __builtin_amdgcn_perm(t0[1], t0[0], 0x0c0c0400u) | __builtin_amdgcn_perm(t0[3], t0[2], 0x04000c0cu);
        const unsigned hi = __builtin_amdgcn_perm(t1[1], t1[0], 0x0c0c0400u) | __builtin_amdgcn_perm(t1[3], t1[2], 0x04000c0cu);
        *(u32x2*)p = (u32x2){lo, hi}; }
    __device__ __forceinline__ void operator()(const f32x4 (&acc)[2][2][4][2], const Unit& u, int ui, PG8_LAS unsigned char* lds, int wr, int wc, int fr, int fq) const {
        const int row0 = u.pm * BM + wr * 64 + fr, col0 = u.pn * BM + wc * 32 + 8 * fq;
        u32x4 bw[8][2];
#define RES_LOAD(g) do { _Pragma("unroll") for (int bj = 0; bj < 2; ++bj) bw[g][bj] = *(const u32x4*)(xr + (size_t)(row0 + ((g) >> 2) * HALF + ((g) & 3) * 16) * D + col0 + bj * HALF); } while (0)
        RES_LOAD(0); RES_LOAD(1); RES_LOAD(2);
#pragma unroll
        for (int g = 0; g < 8; ++g) { const int ai = g >> 2, m = g & 3;
            if (g + 3 < 8) RES_LOAD(g + 3);
            const size_t r = (size_t)(row0 + ai * HALF + m * 16), off = r * D + col0; float sq = 0.f, qs = 0.f;
            if constexpr (A8OUT) { if (a8) qs = *(const PG8_LAS float*)(lds + RSTAB_OFF + ((ui >> 8) * 256 + wr * 64 + fr + ai * HALF + m * 16) * 4); }
#pragma unroll
            for (int bj = 0; bj < 2; ++bj) { const u32x4 b = bw[g][bj];
                const f32x4 x0 = (f32x4){bflo(b.x), bfhi(b.x), bflo(b.y), bfhi(b.y)} + acc[ai][bj][m][0], x1 = (f32x4){bflo(b.z), bfhi(b.z), bflo(b.w), bfhi(b.w)} + acc[ai][bj][m][1];
                sq += (x0[0] * x0[0] + x0[1] * x0[1]) + (x0[2] * x0[2] + x0[3] * x0[3]) + (x1[0] * x1[0] + x1[1] * x1[1]) + (x1[2] * x1[2] + x1[3] * x1[3]);
                u32x4 w; w.x = cvtpk(x0[0], x0[1]); w.y = cvtpk(x0[2], x0[3]); w.z = cvtpk(x1[0], x1[1]); w.w = cvtpk(x1[2], x1[3]);
                *(u32x4*)(xout + off + bj * HALF) = w;
                if constexpr (A8OUT) { if (a8) q8store(x0, x1, qs, a8 + r * 1024 + col0 + bj * HALF); } }
            if constexpr (A8OUT) { if (a8 && u.pn == 0 && wc == 0 && fq == 0) qsinv[r] = __builtin_amdgcn_rcpf(qs); }
            sq += __shfl_xor(sq, 16); sq += __shfl_xor(sq, 32);
            if (fq == 0) ssq[r * 16 + u.pn * 4 + wc] = sq; }
#undef RES_LOAD
    }
};
struct EpiFinal {
    static constexpr bool PERM = true, HAS_MID = false, HAS_PREP = false, HAS_COLTAB = false;
    const bf16_t* xr; float* out; float* slots; unsigned* cnt; const float* gv;
    __device__ __forceinline__ void operator()(f32x4 (&acc)[2][2][4][2], const Unit& u, int ui, PG8_LAS unsigned char* lds, int wr, int wc, int fr, int fq) const {
        const int row0 = u.pm * BM + wr * 64 + fr, col0 = u.pn * BM + wc * 32 + 8 * fq;
        u32x4 bw[8][2];
#define RES_LOAD(g) do { _Pragma("unroll") for (int bj = 0; bj < 2; ++bj) bw[g][bj] = *(const u32x4*)(xr + (size_t)(row0 + ((g) >> 2) * HALF + ((g) & 3) * 16) * D + col0 + bj * HALF); } while (0)
        RES_LOAD(0); RES_LOAD(1); RES_LOAD(2);
#pragma unroll
        for (int g = 0; g < 8; ++g) { const int ai = g >> 2, m = g & 3;
            if (g + 3 < 8) RES_LOAD(g + 3);
            const size_t r = (size_t)(row0 + ai * HALF + m * 16); float sq = 0.f;
#pragma unroll
            for (int bj = 0; bj < 2; ++bj) { const u32x4 b = bw[g][bj];
                const f32x4 x0 = (f32x4){bflo(b.x), bfhi(b.x), bflo(b.y), bfhi(b.y)} + acc[ai][bj][m][0], x1 = (f32x4){bflo(b.z), bfhi(b.z), bflo(b.w), bfhi(b.w)} + acc[ai][bj][m][1];
                sq += (x0[0] * x0[0] + x0[1] * x0[1]) + (x0[2] * x0[2] + x0[3] * x0[3]) + (x1[0] * x1[0] + x1[1] * x1[1]) + (x1[2] * x1[2] + x1[3] * x1[3]);
                acc[ai][bj][m][0] = x0; acc[ai][bj][m][1] = x1; }
            sq += __shfl_xor(sq, 16); sq += __shfl_xor(sq, 32);
            if (fq == 0) __hip_atomic_store(slots + r * 16 + u.pn * 4 + wc, sq, __ATOMIC_RELAXED, __HIP_MEMORY_SCOPE_AGENT); }
#undef RES_LOAD
        asm volatile("s_waitcnt vmcnt(0)" ::: "memory");
        unsigned* c = cnt + u.pm * 16;
        if (fr == 0 && fq == 0) (void)__hip_atomic_fetch_add(c, 1u, __ATOMIC_RELAXED, __HIP_MEMORY_SCOPE_AGENT);
        { unsigned sp = 0u; while (__hip_atomic_load(c, __ATOMIC_RELAXED, __HIP_MEMORY_SCOPE_AGENT) < 32u) { __builtin_amdgcn_s_sleep(2); if (++sp > (1u << 22)) break; } }
        asm volatile("" ::: "memory");
        f32x4 gq[2][2];
#pragma unroll
        for (int bj = 0; bj < 2; ++bj)
#pragma unroll
            for (int n = 0; n < 2; ++n) gq[bj][n] = *(const f32x4*)(gv + col0 + bj * HALF + 4 * n);
#pragma unroll
        for (int g = 0; g < 8; ++g) { const int ai = g >> 2, m = g & 3; const size_t r = (size_t)(row0 + ai * HALF + m * 16);
            const unsigned long long* sp = (const unsigned long long*)(slots + r * 16 + 4 * fq);
            const unsigned long long a = __hip_atomic_load(sp, __ATOMIC_RELAXED, __HIP_MEMORY_SCOPE_AGENT), b = __hip_atomic_load(sp + 1, __ATOMIC_RELAXED, __HIP_MEMORY_SCOPE_AGENT);
            float s = (__uint_as_float((unsigned)a) + __uint_as_float((unsigned)(a >> 32))) + (__uint_as_float((unsigned)b) + __uint_as_float((unsigned)(b >> 32)));
            s += __shfl_xor(s, 16); s += __shfl_xor(s, 32);
            const float rstd = 1.f / sqrtf(s * (1.f / D) + EPS);
#pragma unroll
            for (int bj = 0; bj < 2; ++bj)
#pragma unroll
                for (int n = 0; n < 2; ++n) *(f32x4*)(out + r * D + col0 + bj * HALF + 4 * n) = acc[ai][bj][m][n] * rstd * gq[bj][n]; }
    }
};
struct EpiSwiglu {
    static constexpr bool PERM = true, HAS_MID = false, HAS_PREP = true, HAS_COLTAB = true;
    bf16_t* H; const float* ssq; const float* qsinv; const float* cs;
    __device__ __forceinline__ void prep(PG8_LAS unsigned char* lds, int i, const Unit& u, int tid) const { if (tid < 256) { const size_t row = (size_t)(u.pm * BM + tid); *(PG8_LAS float*)(lds + RSTAB_OFF + (i * 256 + tid) * 4) = rstd_of(ssq + row * 16) * qsinv[row]; } }
    __device__ __forceinline__ void operator()(const f32x4 (&acc)[2][2][4][2], const Unit& u, int ui, PG8_LAS unsigned char* lds, int wr, int wc, int fr, int fq) const {
        const int row0 = u.pm * BM + wr * 64 + fr, col0 = u.pn * HALF + wc * 32 + 8 * fq, cc0 = u.pn * BM + wc * 32 + 8 * fq;
        f32x4 cf[2][2];
#pragma unroll
        for (int bj = 0; bj < 2; ++bj)
#pragma unroll
            for (int n = 0; n < 2; ++n) cf[bj][n] = *(const PG8_LAS f32x4*)(lds + CFTAB_OFF + (ui & 1) * 1024 + (wc * 32 + 8 * fq + bj * HALF + 4 * n) * 4);
#pragma unroll
        for (int ai = 0; ai < 2; ++ai)
#pragma unroll
            for (int m = 0; m < 4; ++m) { float o[8]; const float rs = *(const PG8_LAS float*)(lds + RSTAB_OFF + ((ui >> 8) * 256 + wr * 64 + fr + ai * HALF + m * 16) * 4);
#pragma unroll
                for (int n = 0; n < 2; ++n) { const i32x4 ig = __builtin_bit_cast(i32x4, acc[ai][0][m][n]), iu = __builtin_bit_cast(i32x4, acc[ai][1][m][n]); const f32x4 cg = cf[0][n] * rs, cu = cf[1][n] * rs;
#pragma unroll
                    for (int j = 0; j < 4; ++j) { const float gt = (float)ig[j] * cg[j], up = (float)iu[j] * cu[j]; o[4 * n + j] = gt * sigm(gt) * up; } }
                u32x4 w; w.x = cvtpk(o[0], o[1]); w.y = cvtpk(o[2], o[3]); w.z = cvtpk(o[4], o[5]); w.w = cvtpk(o[6], o[7]);
                *(u32x4*)(H + (size_t)(row0 + ai * HALF + m * 16) * FF + col0) = w; }
    }
};
}

typedef GAS unsigned gu32;
#define RLX_AGENT __ATOMIC_RELAXED, __HIP_MEMORY_SCOPE_AGENT
#define LDS_WAIT() asm volatile("s_waitcnt lgkmcnt(0)" ::: "memory")
#define VM_WAIT() asm volatile("s_waitcnt vmcnt(0)" ::: "memory")

#define XB_TMO      128
#define XB_XCNT(j)  (256  + 64 * (j))
#define XB_XSUB(j)  (1280 + 64 * (j))
#define XB_XGEN(j)  (2304 + 64 * (j))
#define XB_TOP      3328
#define XB_TOPGEN   3392
#define XCD_BAR_WORDS 3456
#define XB_SPIN_CAP (1u << 18)
__device__ __forceinline__ unsigned xb_ld(unsigned* p)              { return __hip_atomic_load(p, __ATOMIC_RELAXED, __HIP_MEMORY_SCOPE_AGENT); }
__device__ __forceinline__ unsigned xb_add(unsigned* p, unsigned v) { return __hip_atomic_fetch_add(p, v, __ATOMIC_RELAXED, __HIP_MEMORY_SCOPE_AGENT); }
__device__ __forceinline__ unsigned xb_xcc_id() { return (unsigned)__builtin_amdgcn_s_getreg((3 << 11) | 20) & 0xFu; }
#define XB_SPIN(cond, bar) do { unsigned _sp = 0; while (cond) { __builtin_amdgcn_s_sleep(1); \
    if ((++_sp & 255u) == 0u) { if (xb_ld(&(bar)[XB_TMO])) break; if (_sp > XB_SPIN_CAP) { atomicAdd(&(bar)[XB_TMO], 1u); break; } } } } while (0)
struct XcdBarrier { unsigned* bar; unsigned x; volatile LAS unsigned* st; };
__device__ __forceinline__ XcdBarrier xcd_barrier_post(unsigned* bar, volatile LAS unsigned* st) {
    XcdBarrier b; b.bar = bar; b.x = xb_xcc_id(); b.st = st;
    if (threadIdx.x == 0) (void)xb_add(&bar[XB_XCNT(b.x)], 1u);
    return b;
}
__device__ __forceinline__ void xcd_barrier_complete(unsigned* bar, unsigned x, unsigned& nloc, unsigned& nx) {
    const unsigned G = gridDim.x * gridDim.y * gridDim.z;
    unsigned sum, cnt, mine, sp = 0u;
    for (;;) {
        sum = 0u; cnt = 0u; mine = 0u;
#pragma unroll
        for (unsigned j = 0; j < 16; ++j) { const unsigned c = xb_ld(&bar[XB_XCNT(j)]); sum += c; cnt += (c > 0u) ? 1u : 0u; mine = (j == x) ? c : mine; }
        if (sum == G) break;
        __builtin_amdgcn_s_sleep(1);
        if ((++sp & 255u) == 0u) { if (xb_ld(&bar[XB_TMO])) break; if (sp > XB_SPIN_CAP) { atomicAdd(&bar[XB_TMO], 1u); break; } }
    }
    nloc = mine > 0u ? mine : 1u; nx = cnt > 0u ? cnt : 1u;
}
__device__ __forceinline__ void xcd_barrier(const XcdBarrier& b) {
    asm volatile("s_waitcnt vmcnt(0)" ::: "memory");
    __syncthreads();
    int tid_ = threadIdx.x; asm volatile("" : "+v"(tid_));
    if (tid_ == 0) {
        unsigned* bar = b.bar; unsigned bx_ = b.x;
        asm volatile("" : "+s"(bar), "+s"(bx_));
        __builtin_amdgcn_s_waitcnt(0);
        unsigned nloc = b.st[0], nx = b.st[1];
        if (nloc == 0u) { xcd_barrier_complete(bar, bx_, nloc, nx); b.st[0] = nloc; b.st[1] = nx; }
        const unsigned old = xb_add(&bar[XB_XSUB(bx_)], 1u);
        const unsigned gen = old / nloc;
        if (old + 1u == (gen + 1u) * nloc) {
            __builtin_amdgcn_fence(__ATOMIC_RELEASE, "agent");
            asm volatile("s_waitcnt vmcnt(0)" ::: "memory");
            const unsigned og = xb_add(&bar[XB_TOP], 1u);
            const unsigned tg = og / nx;
            if (og + 1u == (tg + 1u) * nx) xb_add(&bar[XB_TOPGEN], 1u);
            else XB_SPIN(xb_ld(&bar[XB_TOPGEN]) == tg, bar);
            __builtin_amdgcn_fence(__ATOMIC_ACQUIRE, "agent");
            xb_add(&bar[XB_XGEN(bx_)], 1u);
            asm volatile("s_waitcnt vmcnt(0)" ::: "memory");
        } else {
            XB_SPIN(xb_ld(&bar[XB_XGEN(bx_)]) == gen, bar);
            __builtin_amdgcn_fence(__ATOMIC_ACQUIRE, "agent");
            asm volatile("s_waitcnt vmcnt(0)" ::: "memory");
        }
    }
    __syncthreads();
}

constexpr int NWAVES = 8;
struct Frame {
    LAS unsigned char* lds;
    int tid0, wave, vcu, G;
    float* out; unsigned char* ws;
};
constexpr int PTR_OFF = LDSCTL_OFF + 128;
typedef const GAS float* gfp;
typedef const GAS f32x4* gf4p;
DI gfp inp(const Frame& F, int i) {
    unsigned a_ = (unsigned)(PTR_OFF + 8 * i); asm volatile("" : "+s"(a_));
    const v2u w = *(const LAS v2u*)(F.lds + a_);
    const unsigned long long p = ((unsigned long long)(unsigned)__builtin_amdgcn_readfirstlane((int)w.y) << 32) | (unsigned)__builtin_amdgcn_readfirstlane((int)w.x);
    return (gfp)p;
}
enum { I_X = 0, I_NMG, I_WIN, I_CLW, I_LWA, I_LBA, I_LWX, I_LBX, I_LAM, I_CMW, I_IGB, I_FGB, I_WOL, I_WOM, I_WOS, I_WO, I_NFG, I_WF1, I_WF2, I_FNG };

#define PHASE_IDS int tid = F.tid0; asm volatile("" : "+v"(tid)); const int lane = tid & 63
DI float wave_sum(float v) {
#pragma unroll
    for (int o = 1; o < 64; o <<= 1) v += __shfl_xor(v, o);
    return v;
}
DI float wave_max(float v) {
#pragma unroll
    for (int o = 1; o < 64; o <<= 1) v = fmaxf(v, __shfl_xor(v, o));
    return v;
}
DI unsigned short f2bf1(float x) { return (unsigned short)(cvtpk(x, 0.f) & 0xffffu); }
DI void unpack8(const v4u w, float (&x)[8]) { x[0] = bflo(w.x); x[1] = bfhi(w.x); x[2] = bflo(w.y); x[3] = bfhi(w.y); x[4] = bflo(w.z); x[5] = bfhi(w.z); x[6] = bflo(w.w); x[7] = bfhi(w.w); }
DI v4u pack8(const float (&x)[8]) { v4u w; w.x = cvtpk(x[0], x[1]); w.y = cvtpk(x[2], x[3]); w.z = cvtpk(x[4], x[5]); w.w = cvtpk(x[6], x[7]); return w; }

DI void tr_item(gfp src, int ld_src, bf16* dst, int ld_dst, LAS float* scr, int lane, gfp gain = nullptr) {
    f32x4 v[8]; float gk[8];
#pragma unroll
    for (int i = 0; i < 8; ++i) { v[i] = *(gf4p)(src + (size_t)((lane >> 3) + 8 * i) * ld_src + 4 * (lane & 7)); gk[i] = gain ? gain[(lane >> 3) + 8 * i] : 1.f; }
#pragma unroll
    for (int i = 0; i < 8; ++i) { LAS float* p = scr + ((lane >> 3) + 8 * i) * 33 + 4 * (lane & 7); p[0] = v[i].x * gk[i]; p[1] = v[i].y * gk[i]; p[2] = v[i].z * gk[i]; p[3] = v[i].w * gk[i]; }
    LDS_WAIT(); asm volatile("" ::: "memory");
    const int c = lane & 7;
#pragma unroll
    for (int j = 0; j < 4; ++j) { const int n = (lane >> 3) + 8 * j; const LAS float* s = scr + (8 * c) * 33 + n;
        v4u o; o.x = cvtpk(s[0 * 33], s[1 * 33]); o.y = cvtpk(s[2 * 33], s[3 * 33]); o.z = cvtpk(s[4 * 33], s[5 * 33]); o.w = cvtpk(s[6 * 33], s[7 * 33]);
        *(v4u*)(dst + (size_t)n * ld_dst + 8 * c) = o; }
    LDS_WAIT(); asm volatile("" ::: "memory");
}
DI void phase_weights(Frame& F, int l) {
    PHASE_IDS;
    LAS float* scr = (LAS float*)(F.lds + F.wave * 16384);
    const int gw = F.vcu * NWAVES + F.wave, NGW = F.G * NWAVES;
    unsigned char* wl = F.ws + WS_WL0 + (size_t)l * WS_WLSTRIDE;
    bf16* WIN = (bf16*)(wl + WO_WIN); bf16* WOUT = (bf16*)(wl + WO_WOUT); bf16* WO = (bf16*)(wl + WO_WO); bf16* WF1 = (bf16*)(wl + WO_WF1); bf16* WF2 = (bf16*)(wl + WO_WF2); bf16* LRUW = (bf16*)(wl + WO_LRUW);
    constexpr int N_WIN = 16 * 73, N_WOUT = 384, N_WO = 512, N_WF1 = 0  , N_WF2 = 44 * 32, N_LRU = 16;
    constexpr int NITEMS = N_WIN + N_WOUT + N_WO + N_WF1 + N_WF2 + N_LRU;
    for (int it = gw; it < NITEMS; it += NGW) {
        int r = it;
        if (r < N_WIN) { const int kb = r / 73, nb = r % 73, sc = (nb == 72) ? 1536 : 32 * nb + (32 * nb >= 1536 ? 8 : 0);
            tr_item(inp(F, I_WIN) + (size_t)l * D * IN_COLS + (size_t)(64 * kb) * IN_COLS + sc, IN_COLS, WIN + (size_t)(32 * nb) * D + 64 * kb, D, scr, lane, inp(F, I_NMG) + l * D + 64 * kb); continue; } r -= N_WIN;
        if (r < N_WOUT) { const int br = r / 128, rr = r % 128, kb = rr / 32, nb = rr % 32; gfp W = inp(F, br == 0 ? I_WOL : (br == 1 ? I_WOM : I_WOS));
            tr_item(W + (size_t)l * 256 * D + (size_t)(64 * kb) * D + 32 * nb, D, WOUT + (size_t)(32 * nb) * 768 + br * 256 + 64 * kb, 768, scr, lane); continue; } r -= N_WOUT;
        if (r < N_WO) { const int kb = r / 32, nb = r % 32;
            tr_item(inp(F, I_WO) + (size_t)l * D * D + (size_t)(64 * kb) * D + 32 * nb, D, WO + (size_t)(32 * nb) * D + 64 * kb, D, scr, lane); continue; } r -= N_WO;
        if (r < N_WF1) { const int kb = r / 176, nb = r % 176, pn = nb / 8, w = nb % 8, sc = (w < 4) ? 128 * pn + 32 * w : FF + 128 * pn + 32 * (w - 4);
            tr_item(inp(F, I_WF1) + (size_t)l * D * 2 * FF + (size_t)(64 * kb) * 2 * FF + sc, 2 * FF, WF1 + (size_t)(32 * nb) * D + 64 * kb, D, scr, lane, inp(F, I_NFG) + l * D + 64 * kb); continue; } r -= N_WF1;
        if (r < N_WF2) { const int kb = r / 32, nb = r % 32;
            tr_item(inp(F, I_WF2) + (size_t)l * FF * D + (size_t)(64 * kb) * D + 32 * nb, D, WF2 + (size_t)(32 * nb) * FF + 64 * kb, FF, scr, lane); continue; } r -= N_WF2;
        { const int gate = r / 8, g = (r / 2) % 4, nb = r % 2; gfp W = inp(F, gate ? I_LWX : I_LWA);
            tr_item(W + (size_t)l * 4 * 4096 + g * 4096 + 32 * nb, 64, LRUW + (size_t)((gate * 4 + g) * 64 + 32 * nb) * 64, 64, scr, lane); }
    }
}
DI void phase_w8(Frame& F) {
    PHASE_IDS;
    LAS float* scr = (LAS float*)(F.lds + F.wave * 16384); LAS float* CM = (LAS float*)(F.lds + 12288);
    for (int it = F.vcu; it < DEPTH * 272; it += F.G) {
        const int l = it / 272, ib = it % 272; const bool ffn = ib >= 96; const int nb = ffn ? ib - 96 : ib;
        const int ldw = ffn ? 2 * FF : IN_COLS;
        gfp src, gain; signed char* W8; float* CS;
        if (!ffn) { src = inp(F, I_WIN) + (size_t)l * D * IN_COLS + 2312 + 32 * nb; gain = inp(F, I_NMG) + l * D;
            W8 = (signed char*)(F.ws + WS_W8 + (size_t)l * 4 * MiB) + (size_t)(32 * nb) * 1024; CS = (float*)(F.ws + WS_W8 + (size_t)l * 4 * MiB + 3 * MiB) + 32 * nb; }
        else { const int pn = nb / 8, w = nb % 8, sc = (w < 4) ? 128 * pn + 32 * w : FF + 128 * pn + 32 * (w - 4);
            unsigned char* wl = F.ws + WS_WL0 + (size_t)l * WS_WLSTRIDE;
            src = inp(F, I_WF1) + (size_t)l * D * 2 * FF + sc; gain = inp(F, I_NFG) + l * D;
            W8 = (signed char*)(wl + WO_W8F) + (size_t)(32 * nb) * 1024; CS = (float*)(wl + WO_CSF) + 32 * nb; }
        f32x4 v[2][8]; float mx[4] = {0.f, 0.f, 0.f, 0.f};
#pragma unroll
        for (int h = 0; h < 2; ++h)
#pragma unroll
            for (int i = 0; i < 8; ++i) { const int k = 128 * F.wave + 64 * h + (lane >> 3) + 8 * i; v[h][i] = *(gf4p)(src + (size_t)k * ldw + 4 * (lane & 7)) * gain[k]; }
#pragma unroll
        for (int h = 0; h < 2; ++h)
#pragma unroll
            for (int i = 0; i < 8; ++i) { mx[0] = fmaxf(mx[0], fabsf(v[h][i].x)); mx[1] = fmaxf(mx[1], fabsf(v[h][i].y)); mx[2] = fmaxf(mx[2], fabsf(v[h][i].z)); mx[3] = fmaxf(mx[3], fabsf(v[h][i].w)); }
#pragma unroll
        for (int e = 0; e < 4; ++e) { mx[e] = fmaxf(mx[e], __shfl_xor(mx[e], 8)); mx[e] = fmaxf(mx[e], __shfl_xor(mx[e], 16)); mx[e] = fmaxf(mx[e], __shfl_xor(mx[e], 32)); }
        __syncthreads();
        if (lane < 8) { CM[F.wave * 32 + 4 * lane + 0] = mx[0]; CM[F.wave * 32 + 4 * lane + 1] = mx[1]; CM[F.wave * 32 + 4 * lane + 2] = mx[2]; CM[F.wave * 32 + 4 * lane + 3] = mx[3]; }
        __syncthreads();
        float sc[4];
#pragma unroll
        for (int e = 0; e < 4; ++e) { float m = 0.f;
#pragma unroll
            for (int w = 0; w < 8; ++w) m = fmaxf(m, CM[w * 32 + 4 * (lane & 7) + e]);
            m = fmaxf(m, 1e-30f); sc[e] = 127.f / m; if (F.wave == 0 && lane < 8) CS[4 * lane + e] = m * (1.f / 127.f); }
#pragma unroll
        for (int h = 0; h < 2; ++h) {
#pragma unroll
            for (int i = 0; i < 8; ++i) { LAS float* p = scr + ((lane >> 3) + 8 * i) * 33 + 4 * (lane & 7); p[0] = v[h][i].x * sc[0]; p[1] = v[h][i].y * sc[1]; p[2] = v[h][i].z * sc[2]; p[3] = v[h][i].w * sc[3]; }
            LDS_WAIT(); asm volatile("" ::: "memory");
#pragma unroll
            for (int c2 = 0; c2 < 2; ++c2) { const int id = lane + 64 * c2, n = id >> 2, kc = id & 3; unsigned w4[4];
#pragma unroll
                for (int q = 0; q < 4; ++q) { unsigned w = 0u;
#pragma unroll
                    for (int j = 0; j < 4; ++j) { const int qi = (int)rintf(scr[(16 * kc + 4 * q + j) * 33 + n]); w |= ((unsigned)qi & 0xffu) << (8 * j); }
                    w4[q] = w; }
                *(v4u*)(W8 + (size_t)n * 1024 + 128 * F.wave + 64 * h + 16 * kc) = (v4u){w4[0], w4[1], w4[2], w4[3]}; }
            LDS_WAIT(); asm volatile("" ::: "memory");
        }
    }
}
DI void phase_x0(Frame& F, gfp xsrc) {
    PHASE_IDS;
    const int gw = F.vcu * NWAVES + F.wave, NGW = F.G * NWAVES;
    bf16* XR = (bf16*)F.out; float* SSQ = (float*)(F.ws + WS_SSQ);
    for (int m = gw; m < M; m += NGW) {
        gf4p xr = (gf4p)(xsrc + (size_t)m * D) + lane;
        f32x4 v[4]; float s2 = 0.f;
#pragma unroll
        for (int j = 0; j < 4; ++j) { v[j] = xr[64 * j]; s2 += (v[j].x * v[j].x + v[j].y * v[j].y) + (v[j].z * v[j].z + v[j].w * v[j].w); }
        s2 = wave_sum(s2);
        v2u* o8 = (v2u*)(XR + (size_t)m * D) + lane;
#pragma unroll
        for (int j = 0; j < 4; ++j) { v2u w; w.x = cvtpk(v[j].x, v[j].y); w.y = cvtpk(v[j].z, v[j].w); o8[64 * j] = w; }
        if (lane < 16) SSQ[(size_t)m * 16 + lane] = (lane == 0) ? s2 : 0.f;
        {
            const float qs = QCLIP / sqrtf(s2 * (1.f / D) + EPS); unsigned* a8 = (unsigned*)(F.ws + WS_A8 + (size_t)m * 1024) + lane;
#pragma unroll
            for (int j = 0; j < 4; ++j) { const int q0 = (int)fminf(fmaxf(rintf(v[j].x * qs), -127.f), 127.f), q1 = (int)fminf(fmaxf(rintf(v[j].y * qs), -127.f), 127.f), q2 = (int)fminf(fmaxf(rintf(v[j].z * qs), -127.f), 127.f), q3 = (int)fminf(fmaxf(rintf(v[j].w * qs), -127.f), 127.f);
                a8[64 * j] = ((unsigned)q0 & 0xffu) | (((unsigned)q1 & 0xffu) << 8) | (((unsigned)q2 & 0xffu) << 16) | ((unsigned)q3 << 24); }
            if (lane == 0) ((float*)(F.ws + WS_QSINV))[m] = 1.f / qs; }
    }
}
DI void phase_final_norm(Frame& F, float* out, gfp gvec) {
    PHASE_IDS;
    const int gw = F.vcu * NWAVES + F.wave, NGW = F.G * NWAVES;
    f32x4 gv[4];
#pragma unroll
    for (int j = 0; j < 4; ++j) gv[j] = *((gf4p)gvec + lane + 64 * j);
    const float* SSQ = (const float*)(F.ws + WS_SSQ); const bf16* XF = (const bf16*)(F.ws + WS_XN);
    for (int m = gw; m < M; m += NGW) {
        f32x4* xr = (f32x4*)(out + (size_t)m * D) + lane; const v2u* xi = (const v2u*)(XF + (size_t)m * D) + lane;
        const float rstd = pg8::rstd_of(SSQ + (size_t)m * 16);
#pragma unroll
        for (int j = 0; j < 4; ++j) { const v2u w = xi[64 * j]; const f32x4 x = {bflo(w.x), bfhi(w.x), bflo(w.y), bfhi(w.y)}; xr[64 * j] = x * rstd * gv[j]; }
    }
}

DI void load_taps(const bf16* PROJ, int b, int pos, int col, v4u (&xk)[4]) {
#pragma unroll
    for (int k = 0; k < 4; ++k) { const int p = pos - 3 + k; xk[k] = (p >= 0) ? *(const v4u*)(PROJ + (size_t)(b * SEQ + p) * NP + col) : (v4u){0u, 0u, 0u, 0u}; }
}
constexpr int XA_PITCH = 528, LRU_GT_OFF = 128 * XA_PITCH;
static_assert(LRU_GT_OFF + 128 * XA_PITCH <= RSTAB_OFF, "LRU LDS map");
template <bool FINAL> DI void lru_item(Frame& F, int l, int b, int ci) {
    PHASE_IDS;
    bf16* PROJ = (bf16*)(F.ws + WS_PROJ); const bf16* LRUW = (const bf16*)(F.ws + WS_WL0 + (size_t)l * WS_WLSTRIDE + WO_LRUW); f32x2* LSUM = (f32x2*)(F.ws + WS_LSUM);
    LAS unsigned char* lds = F.lds;
    const int c8 = (tid & 31) * 8, t0 = tid >> 5;
    v4u gt[8];
    const int g = F.wave >> 1, jh = F.wave & 1, r = lane & 31, hh = lane >> 5, c = g * 64 + jh * 32 + r;
    bf16x8 wrf[4], wif[4];
#pragma unroll
    for (int ks = 0; ks < 4; ++ks) { wrf[ks] = *(const bf16x8*)(LRUW + (size_t)((0 * 4 + g) * 64 + jh * 32 + r) * 64 + 16 * ks + 8 * hh); wif[ks] = *(const bf16x8*)(LRUW + (size_t)((1 * 4 + g) * 64 + jh * 32 + r) * 64 + 16 * ks + 8 * hh); }
    const float ba = inp(F, I_LBA)[l * 256 + c], bx = inp(F, I_LBX)[l * 256 + c], lam = inp(F, I_LAM)[l * 256 + c];
    v4u xk[2][4][4];
#pragma unroll
    for (int hb = 0; hb < 2; ++hb)
#pragma unroll
        for (int i = 0; i < 4; ++i) load_taps(PROJ, b, ci * LCH + t0 + 16 * (4 * hb + i), C_LX + c8, xk[hb][i]);
    __syncthreads();
    {
        gfp cw = inp(F, I_CLW) + l * 1024 + c8;
#pragma unroll
        for (int hb = 0; hb < 2; ++hb) {
#pragma unroll
            for (int i = 0; i < 4; ++i) { float acc[8];
#pragma unroll
                for (int e = 0; e < 8; ++e) acc[e] = 0.f;
#pragma unroll
                for (int k = 0; k < 4; ++k) { float x[8]; unpack8(xk[hb][i][k], x); const f32x4 wa = *(gf4p)(cw + k * 256), wb = *(gf4p)(cw + k * 256 + 4);
                    acc[0] += wa.x * x[0]; acc[1] += wa.y * x[1]; acc[2] += wa.z * x[2]; acc[3] += wa.w * x[3]; acc[4] += wb.x * x[4]; acc[5] += wb.y * x[5]; acc[6] += wb.z * x[6]; acc[7] += wb.w * x[7]; }
                *(LAS v4u*)(lds + (t0 + 16 * (4 * hb + i)) * XA_PITCH + c8 * 2) = pack8(acc); } }
    }
    if (FINAL) {
#pragma unroll
        for (int i = 0; i < 8; ++i) gt[i] = *(const v4u*)(PROJ + (size_t)(b * SEQ + ci * LCH + t0 + 16 * i) * NP + C_LG + c8);
    }
    if (FINAL) {
        const int j0 = (ci * F.wave) / 8, j1 = (ci * (F.wave + 1)) / 8;
        float A[4] = {1.f, 1.f, 1.f, 1.f}, Bv[4] = {0.f, 0.f, 0.f, 0.f};
        for (int j = j0; j < j1; j += 8) { f32x2 sm[8][4];
#pragma unroll
            for (int jj = 0; jj < 8; ++jj) { const int jc = (j + jj < j1) ? j + jj : j1 - 1;
#pragma unroll
                for (int q = 0; q < 4; ++q) sm[jj][q] = LSUM[(size_t)(b * NLCH + jc) * 256 + lane + 64 * q]; }
#pragma unroll
            for (int jj = 0; jj < 8; ++jj) if (j + jj < j1) {
#pragma unroll
                for (int q = 0; q < 4; ++q) { Bv[q] = sm[jj][q].x * Bv[q] + sm[jj][q].y; A[q] *= sm[jj][q].x; } } }
#pragma unroll
        for (int q = 0; q < 4; ++q) *(LAS f32x2*)(lds + LRU_GT_OFF + (F.wave * 256 + lane + 64 * q) * 8) = (f32x2){A[q], Bv[q]};
    }
    __syncthreads();
    const float sp8 = 8.f * softplus(-lam);
    float carry = 0.f, Atot = 1.f;
    if (FINAL) {
#pragma unroll
        for (int w = 0; w < 8; ++w) { const f32x2 p = *(const LAS f32x2*)(lds + LRU_GT_OFF + (w * 256 + c) * 8); carry = p.x * carry + p.y; }
        __syncthreads();
#pragma unroll
        for (int i = 0; i < 8; ++i) *(LAS v4u*)(lds + LRU_GT_OFF + (t0 + 16 * i) * XA_PITCH + c8 * 2) = gt[i];
        __syncthreads();
    }
    for (int tt = 0; tt < 4; ++tt) {
        f32x16 accr, acci;
#pragma unroll
        for (int i = 0; i < 16; ++i) { accr[i] = 0.f; acci[i] = 0.f; }
#pragma unroll
        for (int ks = 0; ks < 4; ++ks) { const bf16x8 a = *(const LAS bf16x8*)(lds + (tt * 32 + tau(r)) * XA_PITCH + (g * 64 + 16 * ks + 8 * hh) * 2); accr = MFMA32(a, wrf[ks], accr); acci = MFMA32(a, wif[ks], acci); }
        float HL[16], PP[16]; float hl = 0.f, pp = 1.f;
#pragma unroll
        for (int reg = 0; reg < 16; ++reg) {
            const float xv = bf2f(*(const LAS unsigned short*)(lds + (tt * 32 + 16 * hh + reg) * XA_PITCH + c * 2));
            const float rg = sigm(accr[reg] + ba), ig = sigm(acci[reg] + bx), la = -sp8 * rg, a = fexp(la), u = __builtin_amdgcn_sqrtf(fmaxf(1.f - a * a, 0.f)) * ig * xv;
            hl = a * hl + u; pp = pp * a; HL[reg] = hl; PP[reg] = pp; }
        const float e0h = __shfl(hl, r), e0p = __shfl(pp, r), e1h = __shfl(hl, r + 32), e1p = __shfl(pp, r + 32);
        const float end0 = e0h + e0p * carry, end1 = e1h + e1p * end0, enter = hh ? end0 : carry;
        carry = end1; Atot *= e0p * e1p;
        if (FINAL) {
#pragma unroll
            for (int reg = 0; reg < 16; ++reg) { const float hv = HL[reg] + PP[reg] * enter; LAS unsigned short* gp = (LAS unsigned short*)(lds + LRU_GT_OFF + (tt * 32 + 16 * hh + reg) * XA_PITCH + c * 2);
                *gp = f2bf1(hv * gelu_tanh(bf2f(*gp))); }
        }
    }
    if (!FINAL) { if (hh == 0) LSUM[(size_t)(b * NLCH + ci) * 256 + c] = (f32x2){Atot, carry}; }
    else {
        __syncthreads();
#pragma unroll
        for (int i = 0; i < 8; ++i) { const size_t row = (size_t)(b * SEQ + ci * LCH + t0 + 16 * i);
            *(v4u*)(PROJ + row * NP + C_LG + c8) = *(const LAS v4u*)(lds + LRU_GT_OFF + (t0 + 16 * i) * XA_PITCH + c8 * 2); }
    }
}

constexpr int CW_LRU = 12288;
DI void lru_item_sp(Frame& F, int l, int b, int ci) {
    PHASE_IDS;
    bf16* PROJ = (bf16*)(F.ws + WS_PROJ); const bf16* LRUW = (const bf16*)(F.ws + WS_WL0 + (size_t)l * WS_WLSTRIDE + WO_LRUW);
    unsigned long long* LSUM = (unsigned long long*)(F.ws + WS_LSUM); unsigned* LCNT = (unsigned*)(F.ws + WS_CTL) + CW_LRU;
    LAS unsigned char* lds = F.lds;
    const int c8 = (tid & 31) * 8, t0 = tid >> 5;
    const int g = F.wave >> 1, jh = F.wave & 1, r = lane & 31, hh = lane >> 5, c = g * 64 + jh * 32 + r;
    bf16x8 wrf[4], wif[4];
#pragma unroll
    for (int ks = 0; ks < 4; ++ks) { wrf[ks] = *(const bf16x8*)(LRUW + (size_t)((0 * 4 + g) * 64 + jh * 32 + r) * 64 + 16 * ks + 8 * hh); wif[ks] = *(const bf16x8*)(LRUW + (size_t)((1 * 4 + g) * 64 + jh * 32 + r) * 64 + 16 * ks + 8 * hh); }
    const float ba = inp(F, I_LBA)[l * 256 + c], bx = inp(F, I_LBX)[l * 256 + c], lam = inp(F, I_LAM)[l * 256 + c];
    v4u xk[2][4][4];
#pragma unroll
    for (int hb = 0; hb < 2; ++hb)
#pragma unroll
        for (int i = 0; i < 4; ++i) load_taps(PROJ, b, ci * LCH + t0 + 16 * (4 * hb + i), C_LX + c8, xk[hb][i]);
    __syncthreads();
    {
        gfp cw = inp(F, I_CLW) + l * 1024 + c8;
#pragma unroll
        for (int hb = 0; hb < 2; ++hb) {
#pragma unroll
            for (int i = 0; i < 4; ++i) { float acc[8];
#pragma unroll
                for (int e = 0; e < 8; ++e) acc[e] = 0.f;
#pragma unroll
                for (int k = 0; k < 4; ++k) { float x[8]; unpack8(xk[hb][i][k], x); const f32x4 wa = *(gf4p)(cw + k * 256), wb = *(gf4p)(cw + k * 256 + 4);
                    acc[0] += wa.x * x[0]; acc[1] += wa.y * x[1]; acc[2] += wa.z * x[2]; acc[3] += wa.w * x[3]; acc[4] += wb.x * x[4]; acc[5] += wb.y * x[5]; acc[6] += wb.z * x[6]; acc[7] += wb.w * x[7]; }
                *(LAS v4u*)(lds + (t0 + 16 * (4 * hb + i)) * XA_PITCH + c8 * 2) = pack8(acc); } }
    }
    {
        v4u gt[8];
#pragma unroll
        for (int i = 0; i < 8; ++i) gt[i] = *(const v4u*)(PROJ + (size_t)(b * SEQ + ci * LCH + t0 + 16 * i) * NP + C_LG + c8);
#pragma unroll
        for (int i = 0; i < 8; ++i) *(LAS v4u*)(lds + LRU_GT_OFF + (t0 + 16 * i) * XA_PITCH + c8 * 2) = gt[i];
    }
    __syncthreads();
    const float sp8 = 8.f * softplus(-lam);
    float HL[4][16], EH0[4], EP0[4], EH1[4], EP1[4]; unsigned PPk[4][8];
    float carry = 0.f, Atot = 1.f;
#pragma unroll
    for (int tt = 0; tt < 4; ++tt) {
        f32x16 accr, acci;
#pragma unroll
        for (int i = 0; i < 16; ++i) { accr[i] = 0.f; acci[i] = 0.f; }
#pragma unroll
        for (int ks = 0; ks < 4; ++ks) { const bf16x8 a = *(const LAS bf16x8*)(lds + (tt * 32 + tau(r)) * XA_PITCH + (g * 64 + 16 * ks + 8 * hh) * 2); accr = MFMA32(a, wrf[ks], accr); acci = MFMA32(a, wif[ks], acci); }
        float hl = 0.f, pp = 1.f, ppv[16];
#pragma unroll
        for (int reg = 0; reg < 16; ++reg) {
            const float xv = bf2f(*(const LAS unsigned short*)(lds + (tt * 32 + 16 * hh + reg) * XA_PITCH + c * 2));
            const float rg = sigm(accr[reg] + ba), ig = sigm(acci[reg] + bx), la = -sp8 * rg, a = fexp(la), u = __builtin_amdgcn_sqrtf(fmaxf(1.f - a * a, 0.f)) * ig * xv;
            hl = a * hl + u; pp = pp * a; HL[tt][reg] = hl; ppv[reg] = pp; }
#pragma unroll
        for (int q = 0; q < 8; ++q) PPk[tt][q] = cvtpk(ppv[2 * q], ppv[2 * q + 1]);
        const float e0h = __shfl(hl, r), e0p = __shfl(pp, r), e1h = __shfl(hl, r + 32), e1p = __shfl(pp, r + 32);
        EH0[tt] = e0h; EP0[tt] = e0p; EH1[tt] = e1h; EP1[tt] = e1p;
        const float end0 = e0h + e0p * carry, end1 = e1h + e1p * end0;
        carry = end1; Atot *= e0p * e1p;
    }
    if (hh == 0) __hip_atomic_store(LSUM + (size_t)(b * NLCH + ci) * 256 + c, ((unsigned long long)__float_as_uint(carry) << 32) | __float_as_uint(Atot), __ATOMIC_RELAXED, __HIP_MEMORY_SCOPE_AGENT);
    asm volatile("s_waitcnt vmcnt(0)" ::: "memory");
    if (lane == 0) (void)__hip_atomic_fetch_add(LCNT + (b * NLCH + ci) * 4, 1u, __ATOMIC_RELAXED, __HIP_MEMORY_SCOPE_AGENT);
    __syncthreads();
    {
        const int j0 = (ci * F.wave) / 8, j1 = (ci * (F.wave + 1)) / 8; const unsigned target = 8u * (unsigned)(l + 1);
        if (lane < j1 - j0) { unsigned* cp = LCNT + (b * NLCH + j0 + lane) * 4; unsigned sp = 0u;
            while (__hip_atomic_load(cp, __ATOMIC_RELAXED, __HIP_MEMORY_SCOPE_AGENT) < target) { __builtin_amdgcn_s_sleep(1); if (++sp > (1u << 22)) break; } }
        asm volatile("" ::: "memory");
        float A[4] = {1.f, 1.f, 1.f, 1.f}, Bv[4] = {0.f, 0.f, 0.f, 0.f};
        for (int j = j0; j < j1; j += 8) { unsigned long long sm[8][4];
#pragma unroll
            for (int jj = 0; jj < 8; ++jj) { const int jc = (j + jj < j1) ? j + jj : j1 - 1;
#pragma unroll
                for (int q = 0; q < 4; ++q) sm[jj][q] = __hip_atomic_load(LSUM + (size_t)(b * NLCH + jc) * 256 + lane + 64 * q, __ATOMIC_RELAXED, __HIP_MEMORY_SCOPE_AGENT); }
#pragma unroll
            for (int jj = 0; jj < 8; ++jj) if (j + jj < j1) {
#pragma unroll
                for (int q = 0; q < 4; ++q) { const float sa = __uint_as_float((unsigned)sm[jj][q]), sb = __uint_as_float((unsigned)(sm[jj][q] >> 32)); Bv[q] = sa * Bv[q] + sb; A[q] *= sa; } } }
#pragma unroll
        for (int q = 0; q < 4; ++q) *(LAS f32x2*)(lds + (F.wave * 256 + lane + 64 * q) * 8) = (f32x2){A[q], Bv[q]};
    }
    __syncthreads();
    carry = 0.f;
#pragma unroll
    for (int w = 0; w < 8; ++w) { const f32x2 p = *(const LAS f32x2*)(lds + (w * 256 + c) * 8); carry = p.x * carry + p.y; }
#pragma unroll
    for (int tt = 0; tt < 4; ++tt) {
        const float end0 = EH0[tt] + EP0[tt] * carry, end1 = EH1[tt] + EP1[tt] * end0, enter = hh ? end0 : carry;
        carry = end1;
#pragma unroll
        for (int reg = 0; reg < 16; ++reg) { const unsigned pw = PPk[tt][reg >> 1]; const float hv = HL[tt][reg] + ((reg & 1) ? bfhi(pw) : bflo(pw)) * enter; LAS unsigned short* gp = (LAS unsigned short*)(lds + LRU_GT_OFF + (tt * 32 + 16 * hh + reg) * XA_PITCH + c * 2);
            *gp = f2bf1(hv * gelu_tanh(bf2f(*gp))); }
    }
    __syncthreads();
    int t0s = t0; asm volatile("" : "+v"(t0s));
#pragma unroll
    for (int i = 0; i < 8; ++i) { const size_t row = (size_t)(b * SEQ + ci * LCH + t0s + 16 * i);
        *(v4u*)(PROJ + row * NP + C_LG + c8) = *(const LAS v4u*)(lds + LRU_GT_OFF + (t0s + 16 * i) * XA_PITCH + c8 * 2); }
}

DI float scan_add(float x, int lane) {
#pragma unroll
    for (int o = 1; o < 64; o <<= 1) { const float t = __shfl_up(x, o); if (lane >= o) x += t; }
    return x;
}
DI float scan_max(float x, int lane) {
#pragma unroll
    for (int o = 1; o < 64; o <<= 1) { const float t = __shfl_up(x, o); if (lane >= o) x = fmaxf(x, t); }
    return x;
}
DI void conv8_silu(const bf16* PROJ, int b, int pos, int col, const float (&w)[4][8], float scale, float (&o)[8]) {
#pragma unroll
    for (int e = 0; e < 8; ++e) o[e] = 0.f;
#pragma unroll
    for (int k = 0; k < 4; ++k) { const int p = pos - 3 + k; if (p >= 0) { float x[8]; unpack8(*(const v4u*)(PROJ + (size_t)(b * SEQ + p) * NP + col), x);
#pragma unroll
        for (int e = 0; e < 8; ++e) o[e] += w[k][e] * x[e]; } }
#pragma unroll
    for (int e = 0; e < 8; ++e) o[e] = siluf(o[e]) * scale;
}
DI void load_cw(gfp cw, float (&w)[4][8]) {
#pragma unroll
    for (int k = 0; k < 4; ++k) { const f32x4 a = *(gf4p)(cw + k * 512), c = *(gf4p)(cw + k * 512 + 4);
        w[k][0] = a.x; w[k][1] = a.y; w[k][2] = a.z; w[k][3] = a.w; w[k][4] = c.x; w[k][5] = c.y; w[k][6] = c.z; w[k][7] = c.w; }
}
DI void conv8_regs(const v4u (&xk)[4], gfp cw  , float scale, float (&o)[8]) {
#pragma unroll
    for (int e = 0; e < 8; ++e) o[e] = 0.f;
#pragma unroll
    for (int k = 0; k < 4; ++k) { float x[8]; unpack8(xk[k], x); const f32x4 a = *(gf4p)(cw + k * 512), c = *(gf4p)(cw + k * 512 + 4);
        o[0] += a.x * x[0]; o[1] += a.y * x[1]; o[2] += a.z * x[2]; o[3] += a.w * x[3]; o[4] += c.x * x[4]; o[5] += c.y * x[5]; o[6] += c.z * x[6]; o[7] += c.w * x[7]; }
#pragma unroll
    for (int e = 0; e < 8; ++e) o[e] = siluf(o[e]) * scale;
}
#define GATHER8(dst, base, pitch, col, ROWEXPR) do { unsigned g_[8]; _Pragma("unroll") for (int j = 0; j < 8; ++j) g_[j] = *(const LAS unsigned short*)((base) + (ROWEXPR) * (pitch) + (col) * 2); \
    v4u w_; w_.x = g_[0] | (g_[1] << 16); w_.y = g_[2] | (g_[3] << 16); w_.z = g_[4] | (g_[5] << 16); w_.w = g_[6] | (g_[7] << 16); dst = __builtin_bit_cast(bf16x8, w_); } while (0)
constexpr int M1_HB = 20480;
DI void m1_item(Frame& F, int l, int b, int cm) {
    PHASE_IDS;
    const bf16* PROJ = (const bf16*)(F.ws + WS_PROJ); const float* IFB = (const float*)(F.ws + WS_IF);
    float* BL = (float*)(F.ws + WS_MSC); float* GG = BL + 2048; float* MST = (float*)(F.ws + WS_MST); float* MSN = (float*)(F.ws + WS_MSN);
    LAS unsigned char* lds = F.lds;
    const int hd = F.wave >> 1, sub = F.wave & 1, r = lane & 31, hh = lane >> 5;
    const int c8i = tid & 31, cc = c8i * 8, head = c8i >> 3, d0 = (c8i & 7) * 8, s0 = tid >> 5;
    v4u xk[4][4], xv[4];
#pragma unroll
    for (int i = 0; i < 4; ++i) { const int pos = cm * MCH + s0 + 16 * i; load_taps(PROJ, b, pos, C_MK + cc, xk[i]); xv[i] = *(const v4u*)(PROJ + (size_t)(b * SEQ + pos) * NP + C_MV + cc); }
    float ip = 0.f, lf = 0.f;
    if (sub == 0) { const size_t row = (size_t)b * SEQ + cm * MCH + lane; ip = IFB[row * 8 + hd]; lf = IFB[row * 8 + 4 + hd]; }
    __syncthreads();
    if (sub == 0) {
        const float bs = scan_add(lf, lane), bL = __shfl(bs, 63), gs = bL - bs + ip, G = wave_max(gs);
        *(LAS float*)(lds + hd * M1_HB + 18432 + lane * 4) = fexp(gs - G);
        if (lane == 0) { BL[(b * 4 + hd) * NMCH + cm] = bL; GG[(b * 4 + hd) * NMCH + cm] = G; }
    }
    { gfp cw = inp(F, I_CMW) + l * 2048 + 256 + cc; LAS unsigned char* hbs = lds + head * M1_HB;
#pragma unroll
      for (int i = 0; i < 4; ++i) { float kv[8]; conv8_regs(xk[i], cw, 0.125f, kv); *(LAS v4u*)(hbs + (s0 + 16 * i) * 144 + d0 * 2) = pack8(kv); } }
    __syncthreads();
    { LAS unsigned char* hbs = lds + head * M1_HB;
#pragma unroll
      for (int i = 0; i < 4; ++i) { const int sidx = s0 + 16 * i; const float ws = *(const LAS float*)(hbs + 18432 + sidx * 4); float vv[8]; unpack8(xv[i], vv);
#pragma unroll
        for (int e = 0; e < 8; ++e) vv[e] *= ws;
        *(LAS v4u*)(hbs + 9216 + sidx * 144 + d0 * 2) = pack8(vv); } }
    __syncthreads();
    {
        LAS unsigned char* hb = lds + hd * M1_HB; const int vt = sub; const size_t base = ((size_t)(b * 4 + hd) * NMCH + cm) * 4096;
        bf16x8 af[4];
#pragma unroll
        for (int ks = 0; ks < 4; ++ks) GATHER8(af[ks], hb + 9216, 144, vt * 32 + r, (16 * ks + 8 * hh + j));
#pragma unroll
        for (int kt = 0; kt < 2; ++kt) { f32x16 acc;
#pragma unroll
            for (int i = 0; i < 16; ++i) acc[i] = 0.f;
#pragma unroll
            for (int ks = 0; ks < 4; ++ks) { bf16x8 bb; GATHER8(bb, hb, 144, kt * 32 + r, (16 * ks + 8 * hh + j)); acc = MFMA32(af[ks], bb, acc); }
#pragma unroll
            for (int reg = 0; reg < 16; ++reg) MST[base + (size_t)(vt * 32 + crow(reg, hh)) * 64 + kt * 32 + r] = acc[reg]; }
        if (tid < 256) { const int hd2 = tid >> 6, k = tid & 63; LAS unsigned char* h2 = lds + hd2 * M1_HB; float sm = 0.f;
#pragma unroll 8
            for (int sidx = 0; sidx < 64; ++sidx) sm += bf2f(*(const LAS unsigned short*)(h2 + sidx * 144 + k * 2)) * *(const LAS float*)(h2 + 18432 + sidx * 4);
            MSN[((size_t)(b * 4 + hd2) * NMCH + cm) * 64 + k] = sm; }
    }
}
DI void m2_scan(Frame& F) {
    PHASE_IDS;
    LAS unsigned char* lds = F.lds;
    LAS float* TH = (LAS float*)lds; LAS float* MM = TH + 256; LAS float* WA = MM + 272; LAS float* WB = WA + 256; LAS float* WT = WB + 256; LAS float* TT = WT + 256;
    const int bh = F.vcu >> 5, e0 = (F.vcu & 31) * 130;
    if (F.vcu >= 256) return;
    const float* BLp = (const float*)(F.ws + WS_MSC) + bh * NMCH; const float* GGp = BLp + 2048; float* MAp = (float*)(F.ws + WS_MSC) + 4096 + bh * NMCH;
    __syncthreads();
    if (F.wave == 0) {
        float bl[4], gg[4], bi[4]; float tot = 0.f;
#pragma unroll
        for (int i = 0; i < 4; ++i) { bl[i] = BLp[4 * lane + i]; gg[i] = GGp[4 * lane + i]; tot += bl[i]; bi[i] = tot; }
        const float incl = scan_add(tot, lane), base = incl - tot;
        float th[4]; float lmax = -3.0e38f;
#pragma unroll
        for (int i = 0; i < 4; ++i) { th[i] = gg[i] - (base + bi[i]); lmax = fmaxf(lmax, th[i]); }
        const float imax = scan_max(lmax, lane); float ex = __shfl_up(imax, 1); if (lane == 0) ex = 0.f; float m = fmaxf(ex, 0.f);
#pragma unroll
        for (int i = 0; i < 4; ++i) { const int c = 4 * lane + i; TH[c] = th[i]; MM[c] = m; if ((F.vcu & 31) == 0) MAp[c] = (base + bi[i] - bl[i]) + m; m = fmaxf(m, th[i]); }
        if (lane == 63) MM[256] = m;
    }
    __syncthreads();
    const int j = tid >> 5, el = tid & 31;
    float x[5][16]; float* ptr[5];
#pragma unroll
    for (int g = 0; g < 5; ++g) { const int eo = g * 32 + el; const bool valid = eo < 130; const int e = e0 + (valid ? eo : 0);
        ptr[g] = (e < 4096) ? (float*)(F.ws + WS_MST) + ((size_t)bh * NMCH + 16 * j) * 4096 + e : (float*)(F.ws + WS_MSN) + ((size_t)bh * NMCH + 16 * j) * 64 + (e - 4096);
        const size_t stride = (e < 4096) ? 4096 : 64;
#pragma unroll
        for (int i = 0; i < 16; ++i) x[g][i] = ptr[g][(size_t)i * stride]; }
    if (tid < 256) { const int c = tid; const float m1 = MM[c + 1]; WA[c] = fexp(MM[c] - m1); WB[c] = fexp(TH[c] - m1); WT[c] = fexp(TH[c] - MM[(c | 15) + 1]); }
    else if (tid < 271) { const int jj = tid - 256; MM[257 + jj] = fexp(MM[16 * jj] - MM[16 * jj + 16]); }
    __syncthreads();
#pragma unroll
    for (int g = 0; g < 5; ++g) {
        float T = 0.f;
#pragma unroll
        for (int i = 0; i < 16; ++i) T += WT[16 * j + i] * x[g][i];
        TT[(g * 16 + j) * 32 + el] = T; }
    __syncthreads();
#pragma unroll
    for (int g = 0; g < 5; ++g) { const int eo = g * 32 + el; const bool valid = eo < 130; const int e = e0 + (valid ? eo : 0); const size_t stride = (e < 4096) ? 4096 : 64;
        float st = 0.f;
        for (int jj = 0; jj < j; ++jj) st = MM[257 + jj] * st + TT[(g * 16 + jj) * 32 + el];
        if (valid) {
#pragma unroll
            for (int i = 0; i < 16; ++i) { const int c = 16 * j + i;
                if (e < 4096) ((unsigned short*)(F.ws + WS_XN))[((size_t)bh * NMCH + c) * 4096 + e] = f2bf1(st);
                else ptr[g][(size_t)i * stride] = st;
                st = WA[c] * st + WB[c] * x[g][i]; } }
    }
    __syncthreads();
}
constexpr int M3_HB = 28672;
DI void m3_item(Frame& F, int l, int b, int cm) {
    PHASE_IDS;
    bf16* PROJ = (bf16*)(F.ws + WS_PROJ); const float* IFB = (const float*)(F.ws + WS_IF);
    const float* MARR = (const float*)(F.ws + WS_MSC) + 4096; const float* MST = (const float*)(F.ws + WS_MST); const float* MSN = (const float*)(F.ws + WS_MSN);
    LAS unsigned char* lds = F.lds;
    const int hd = F.wave >> 1, sub = F.wave & 1, r = lane & 31, hh = lane >> 5;
    const int c8i = tid & 31, cc = c8i * 8, head = c8i >> 3, d0 = (c8i & 7) * 8, s0 = tid >> 5; LAS unsigned char* hbs = lds + head * M3_HB;
    v4u xq[4][4], xk2[4][4], xv[4];
#pragma unroll
    for (int i = 0; i < 4; ++i) { const int pos = cm * MCH + s0 + 16 * i; load_taps(PROJ, b, pos, C_MQ + cc, xq[i]); load_taps(PROJ, b, pos, C_MK + cc, xk2[i]); xv[i] = *(const v4u*)(PROJ + (size_t)(b * SEQ + pos) * NP + C_MV + cc); }
    float ip = 0.f, lf = 0.f; const float mprev0 = MARR[(b * 4 + hd) * NMCH + cm];
    if (sub == 0) { const size_t row = (size_t)b * SEQ + cm * MCH + lane; ip = IFB[row * 8 + hd]; lf = IFB[row * 8 + 4 + hd]; }
    v4u gq[4];
#pragma unroll
    for (int i = 0; i < 4; ++i) gq[i] = *(const v4u*)(PROJ + (size_t)(b * SEQ + cm * MCH + s0 + 16 * i) * NP + C_MO + cc);
    __syncthreads();
    if (sub == 0) {
        const float bs = scan_add(lf, lane), es = ip - bs, em = scan_max(es, lane), mh = fmaxf(em, mprev0);
        LAS float* t = (LAS float*)(lds + hd * M3_HB + 27648); t[lane] = es; t[64 + lane] = mh; t[128 + lane] = bs;
    }
#pragma unroll
    for (int i = 0; i < 4; ++i) { float qv[8]; conv8_regs(xq[i], inp(F, I_CMW) + l * 2048 + cc, 1.f, qv); *(LAS v4u*)(hbs + (s0 + 16 * i) * 144 + d0 * 2) = pack8(qv); *(LAS v4u*)(hbs + 18432 + (s0 + 16 * i) * 144 + d0 * 2) = xv[i]; }
#pragma unroll
    for (int i = 0; i < 4; ++i) { float kv[8]; conv8_regs(xk2[i], inp(F, I_CMW) + l * 2048 + 256 + cc, 0.125f, kv); *(LAS v4u*)(hbs + 9216 + (s0 + 16 * i) * 144 + d0 * 2) = pack8(kv); }
    bf16x8 cfb[2][4]; f32x4 nfr[8];
    { const bf16* Cst = (const bf16*)(F.ws + WS_XN) + ((size_t)(b * 4 + hd) * NMCH + cm) * 4096; const float* nst = MSN + ((size_t)(b * 4 + hd) * NMCH + cm) * 64 + 32 * hh;
#pragma unroll
      for (int vt = 0; vt < 2; ++vt)
#pragma unroll
        for (int ks = 0; ks < 4; ++ks) cfb[vt][ks] = *(const bf16x8*)(Cst + (size_t)(vt * 32 + r) * 64 + 16 * ks + 8 * hh);
#pragma unroll
      for (int q = 0; q < 8; ++q) nfr[q] = *(const f32x4*)(nst + 4 * q); }
    __syncthreads();
    f32x16 outv[2];
    {
        LAS unsigned char* hb = lds + hd * M3_HB; const LAS float* tb = (const LAS float*)(hb + 27648);
        const int tw = sub, t = tw * 32 + r; const int bh = b * 4 + hd;
        bf16x8 qf[4];
#pragma unroll
        for (int ks = 0; ks < 4; ++ks) qf[ks] = *(const LAS bf16x8*)(hb + (tw * 32 + r) * 144 + (16 * ks + 8 * hh) * 2);
        const float mh = tb[64 + t], bt = tb[128 + t], mprev = mprev0, decay = fexp(mprev - mh);
        f32x16 accN[2], accI[2];
#pragma unroll
        for (int i = 0; i < 16; ++i) { accN[0][i] = 0.f; accN[1][i] = 0.f; accI[0][i] = 0.f; accI[1][i] = 0.f; }
        float dsum = 0.f;
        for (int st = 0; st <= tw; ++st) {
            f32x16 sacc;
#pragma unroll
            for (int i = 0; i < 16; ++i) sacc[i] = 0.f;
#pragma unroll
            for (int ks = 0; ks < 4; ++ks) { const bf16x8 kf = *(const LAS bf16x8*)(hb + 9216 + (st * 32 + r) * 144 + (16 * ks + 8 * hh) * 2); sacc = MFMA32(kf, qf[ks], sacc); }
            float p[16];
#pragma unroll
            for (int reg = 0; reg < 16; ++reg) { const int s = st * 32 + crow(reg, hh); const float ev = fexp(tb[s] - mh) * sacc[reg]; p[reg] = (s <= t) ? ev : 0.f; dsum += p[reg]; }
#pragma unroll
            for (int k2 = 0; k2 < 2; ++k2) { v4u pw; pw.x = cvtpk(p[8 * k2], p[8 * k2 + 1]); pw.y = cvtpk(p[8 * k2 + 2], p[8 * k2 + 3]); pw.z = cvtpk(p[8 * k2 + 4], p[8 * k2 + 5]); pw.w = cvtpk(p[8 * k2 + 6], p[8 * k2 + 7]);
                const bf16x8 bfg = __builtin_bit_cast(bf16x8, pw);
#pragma unroll
                for (int vt = 0; vt < 2; ++vt) { bf16x8 av; GATHER8(av, hb + 18432, 144, vt * 32 + r, (st * 32 + 16 * k2 + 8 * (j >> 2) + 4 * hh + (j & 3)));
                    accN[vt] = MFMA32(av, bfg, accN[vt]); } }
        }
#pragma unroll
        for (int vt = 0; vt < 2; ++vt)
#pragma unroll
            for (int ks = 0; ks < 4; ++ks) accI[vt] = MFMA32(cfb[vt][ks], qf[ks], accI[vt]);
        float nq = 0.f;
#pragma unroll
        for (int q = 0; q < 4; ++q) { float x[8]; unpack8(*(const LAS v4u*)(hb + t * 144 + (32 * hh + 8 * q) * 2), x);
            nq += (x[0] * nfr[2 * q].x + x[1] * nfr[2 * q].y) + (x[2] * nfr[2 * q].z + x[3] * nfr[2 * q].w) + (x[4] * nfr[2 * q + 1].x + x[5] * nfr[2 * q + 1].y) + (x[6] * nfr[2 * q + 1].z + x[7] * nfr[2 * q + 1].w); }
        nq += __shfl_xor(nq, 32); dsum += __shfl_xor(dsum, 32);
        const float den = dsum + decay * nq, inv = frcp(fmaxf(fabsf(den), fexp(-(bt + mh))));
#pragma unroll
        for (int vt = 0; vt < 2; ++vt)
#pragma unroll
            for (int reg = 0; reg < 16; ++reg) outv[vt][reg] = (accN[vt][reg] + decay * accI[vt][reg]) * inv;
    }
    __syncthreads();
    {
        LAS unsigned char* hb = lds + hd * M3_HB; const int t = sub * 32 + r;
#pragma unroll
        for (int vt = 0; vt < 2; ++vt)
#pragma unroll
            for (int g4 = 0; g4 < 4; ++g4) { v2u w; w.x = cvtpk(outv[vt][4 * g4], outv[vt][4 * g4 + 1]); w.y = cvtpk(outv[vt][4 * g4 + 2], outv[vt][4 * g4 + 3]);
                *(LAS v2u*)(hb + t * 144 + (vt * 32 + 8 * g4 + 4 * hh) * 2) = w; }
    }
    __syncthreads();
    {
#pragma unroll
        for (int i = 0; i < 4; ++i) { const int s = s0 + 16 * i; float hv[8], gv[8];
            unpack8(*(const LAS v4u*)(lds + head * M3_HB + s * 144 + d0 * 2), hv);
            bf16* gp = PROJ + (size_t)(b * SEQ + cm * MCH + s) * NP + C_MO + cc; unpack8(gq[i], gv);
#pragma unroll
            for (int e = 0; e < 8; ++e) hv[e] *= sigm(gv[e]);
            *(v4u*)gp = pack8(hv); }
    }
}

constexpr int ATT_WB = 5120;
DI void att_item(Frame& F, int it) {
    PHASE_IDS;
    bf16* PROJ = (bf16*)(F.ws + WS_PROJ);
    const int qb = it & 511, h = (it >> 9) & 3, b = it >> 11, r = lane & 31, hh = lane >> 5;
    LAS unsigned char* wl = F.lds + F.wave * ATT_WB;
    const size_t rowbase = (size_t)b * SEQ; const int Q0 = qb * 32, qpos = Q0 + r;
    bf16x8 qf[4];
#pragma unroll
    for (int ks = 0; ks < 4; ++ks) qf[ks] = *(const bf16x8*)(PROJ + (rowbase + Q0 + r) * NP + C_SQ + h * 64 + 16 * ks + 8 * hh);
    f32x16 oacc[2];
#pragma unroll
    for (int i = 0; i < 16; ++i) { oacc[0][i] = 0.f; oacc[1][i] = 0.f; }
    float carry = 0.f;
    bf16x8 kfn[4]; v4u vrn[4];
#define ATT_LOAD(KT) do { const int k0_ = (KT) * 32; _Pragma("unroll") for (int ks = 0; ks < 4; ++ks) kfn[ks] = *(const bf16x8*)(PROJ + (rowbase + k0_ + tau(r)) * NP + C_SK + h * 64 + 16 * ks + 8 * hh); \
        _Pragma("unroll") for (int i = 0; i < 4; ++i) vrn[i] = *(const v4u*)(PROJ + (rowbase + k0_ + r) * NP + C_SV + h * 64 + (hh + 2 * i) * 8); } while (0)
    ATT_LOAD(qb);
    for (int kt = qb; kt >= 0; --kt) {
        const int key0 = kt * 32;
        bf16x8 kf[4]; v4u vraw[4];
#pragma unroll
        for (int i = 0; i < 4; ++i) { kf[i] = kfn[i]; vraw[i] = vrn[i]; }
        if (kt > 0) ATT_LOAD(kt - 1);
        f32x16 sacc;
#pragma unroll
        for (int i = 0; i < 16; ++i) sacc[i] = 0.f;
#pragma unroll
        for (int ks = 0; ks < 4; ++ks) sacc = MFMA32(kf[ks], qf[ks], sacc);
#pragma unroll
        for (int i = 0; i < 4; ++i) { const int key = r, d8 = (hh + 2 * i) * 8; const unsigned w[4] = {vraw[i].x, vraw[i].y, vraw[i].z, vraw[i].w};
#pragma unroll
            for (int e = 0; e < 4; ++e) { *(LAS unsigned short*)(wl + (d8 + 2 * e) * 80 + key * 2) = (unsigned short)(w[e] & 0xffffu); *(LAS unsigned short*)(wl + (d8 + 2 * e + 1) * 80 + key * 2) = (unsigned short)(w[e] >> 16); } }
        float bt[16], om[16]; const bool diag = (kt == qb);
#pragma unroll
        for (int reg = 0; reg < 16; ++reg) { const float zz = sacc[reg] * 0.125f, t = fexp(-fabsf(zz)), d = frcp(1.f + t), td = t * d; const bool valid = !diag || (key0 + 16 * hh + reg < qpos), pos = zz >= 0.f;
            bt[reg] = valid ? (pos ? d : td) : 0.f; om[reg] = valid ? (pos ? td : d) : 1.f; }
        float run = 1.f, sufx[16];
#pragma unroll
        for (int reg = 15; reg >= 0; --reg) { sufx[reg] = run; run *= om[reg]; }
        const float tot_o = __shfl_xor(run, 32), basev = fexp(carry) * (hh == 0 ? tot_o : 1.f);
        float pa[16];
#pragma unroll
        for (int reg = 0; reg < 16; ++reg) pa[reg] = bt[reg] * sufx[reg] * basev;
        carry += __logf(run * tot_o);
        asm volatile("s_waitcnt lgkmcnt(0)" ::: "memory");
#pragma unroll
        for (int k2 = 0; k2 < 2; ++k2) { v4u pw; pw.x = cvtpk(pa[8 * k2], pa[8 * k2 + 1]); pw.y = cvtpk(pa[8 * k2 + 2], pa[8 * k2 + 3]); pw.z = cvtpk(pa[8 * k2 + 4], pa[8 * k2 + 5]); pw.w = cvtpk(pa[8 * k2 + 6], pa[8 * k2 + 7]);
            const bf16x8 bfg = __builtin_bit_cast(bf16x8, pw);
#pragma unroll
            for (int dt = 0; dt < 2; ++dt) { const bf16x8 af = *(const LAS bf16x8*)(wl + (dt * 32 + r) * 80 + (16 * hh + 8 * k2) * 2); oacc[dt] = MFMA32(af, bfg, oacc[dt]); } }
        asm volatile("s_waitcnt lgkmcnt(0)" ::: "memory");
        if (__all(carry < -88.f)) break;
    }
#pragma unroll
    for (int dt = 0; dt < 2; ++dt)
#pragma unroll
        for (int g4 = 0; g4 < 4; ++g4) { v2u w; w.x = cvtpk(oacc[dt][4 * g4], oacc[dt][4 * g4 + 1]); w.y = cvtpk(oacc[dt][4 * g4 + 2], oacc[dt][4 * g4 + 3]);
            *(LAS v2u*)(wl + r * 144 + (dt * 32 + 8 * g4 + 4 * hh) * 2) = w; }
    asm volatile("s_waitcnt lgkmcnt(0)" ::: "memory");
#pragma unroll
    for (int i = 0; i < 4; ++i) { const int id = lane + 64 * i, row = id >> 3, c8 = id & 7;
        *(v4u*)(PROJ + (rowbase + Q0 + row) * NP + C_SQ + h * 64 + c8 * 8) = *(const LAS v4u*)(wl + row * 144 + c8 * 16); }
    asm volatile("s_waitcnt lgkmcnt(0)" ::: "memory");
}

DI int OPQ_BX() { int bx = blockIdx.x; asm volatile("" : "+s"(bx)); return bx; }
struct Args { const float* in[20]; float* out; unsigned char* ws; };
constexpr int CW_BAR = 4096, CW_FIN = 10240;
__global__ void __launch_bounds__(NWAVES * 64, 2) trunk_fwd(Args args) {
    extern __shared__ __attribute__((aligned(16))) unsigned char lds_raw[];
    Frame F;
    F.lds = (LAS unsigned char*)lds_raw;
    F.tid0 = threadIdx.x; F.wave = __builtin_amdgcn_readfirstlane(F.tid0 >> 6);
    F.G = gridDim.x; { const int bx = blockIdx.x; F.vcu = (F.G % 8 == 0) ? (bx % 8) * (F.G / 8) + bx / 8 : bx; }
    F.out = args.out; F.ws = args.ws;
    volatile LAS unsigned* MISC = (volatile LAS unsigned*)(F.lds + MISC_OFF);
    for (int u = F.tid0; u < (LDS_BYTES - LDSCTL_OFF) / 4; u += NWAVES * 64) ((LAS unsigned*)(F.lds + LDSCTL_OFF))[u] = 0u;
    __syncthreads();
    if (F.tid0 < 20) *(LAS unsigned long long*)(F.lds + PTR_OFF + 8 * F.tid0) = (unsigned long long)args.in[F.tid0];
    __syncthreads();
    XcdBarrier bar = xcd_barrier_post((unsigned*)(F.ws + WS_CTL) + CW_BAR, MISC + 8);
#define GRID_BAR() xcd_barrier(bar)
    bf16* XN = (bf16*)(F.ws + WS_XN); bf16* PROJ = (bf16*)(F.ws + WS_PROJ); bf16* XR2 = (bf16*)(F.ws + WS_GATES + 32 * MiB);
    const int gw = F.vcu * NWAVES + F.wave, NGW = F.G * NWAVES;

    bf16* XR = (bf16*)F.out;
    phase_weights(F, 0); phase_weights(F, 1);
    __syncthreads();
    phase_w8(F);
    phase_x0(F, inp(F, I_X));
    GRID_BAR();
    for (int l = 0; l < DEPTH; ++l) {
        float* SSQ = (float*)(F.ws + WS_SSQ); unsigned char* wl = F.ws + WS_WL0 + (size_t)l * WS_WLSTRIDE;
        { pg8::Gemm g{XR, (const bf16*)(wl + WO_WIN), M, 2560, D, D, D}; pg8::StaticOrder S; S.init(M, 2560, F.G, OPQ_BX());
          pg8::EpiProj E{PROJ, SSQ  , (float*)(F.ws + WS_IF), (const float*)(inp(F, I_IGB) + l * 4), (const float*)(inp(F, I_FGB) + l * 4)};
          pg8::gemm_phase<pg8::EpiProj, pg8::StaticOrder, pg8::AMapLinear, true, true>(F.lds, g, S, E, pg8::AMapLinear{}); }
        { pg8::Gemm g{(const bf16*)(F.ws + WS_A8), (const bf16*)(F.ws + WS_W8 + (size_t)l * 4 * MiB), M, 3072, 512, 512, 512}; pg8::StaticOrder S; S.init(M, 3072, F.G, OPQ_BX());
          pg8::EpiGates E{(bf16*)(F.ws + WS_GATES), SSQ, (const float*)(F.ws + WS_QSINV), (const float*)(F.ws + WS_W8 + (size_t)l * 4 * MiB + 3 * MiB)};
          pg8::gemm_phase<pg8::EpiGates, pg8::StaticOrder, pg8::AMapLinear, true, true, true>(F.lds, g, S, E, pg8::AMapLinear{}); }
        GRID_BAR();
        if (F.G == BATCH * NLCH) lru_item_sp(F, l, F.vcu / NLCH, F.vcu % NLCH);
        else for (int it = F.vcu; it < BATCH * NLCH; it += F.G) lru_item<false>(F, l, it / NLCH, it % NLCH);
        for (int it = F.vcu; it < BATCH * NMCH; it += F.G) m1_item(F, l, it / NMCH, it % NMCH);
        __syncthreads();
        for (int it = gw; it < BATCH * 4 * (SEQ / 32); it += NGW) att_item(F, it);
        GRID_BAR();
        m2_scan(F);
        if (F.G != BATCH * NLCH) for (int it = F.vcu; it < BATCH * NLCH; it += F.G) lru_item<true>(F, l, it / NLCH, it % NLCH);
        GRID_BAR();
        for (int it = F.vcu; it < BATCH * NMCH; it += F.G) m3_item(F, l, it / NMCH, it % NMCH);
        GRID_BAR();
        { pg8::Gemm g{PROJ, (const bf16*)(wl + WO_WOUT), M, D, 768, NP, 768}; pg8::StaticOrder S; S.init(M, D, F.G, OPQ_BX()); pg8::EpiMerge E{(const bf16*)(F.ws + WS_GATES), XN};
          pg8::gemm_phase<pg8::EpiMerge, pg8::StaticOrder, pg8::AMap3, true, true>(F.lds, g, S, E, pg8::AMap3{}); }
        GRID_BAR();
        { pg8::Gemm g{XN, (const bf16*)(wl + WO_WO), M, D, D, D, D}; pg8::StaticOrder S; S.init(M, D, F.G, OPQ_BX());
          pg8::EpiRes<true> E{(const float*)nullptr, XR, (l + 1 < DEPTH) ? XR : XR2  , SSQ + (size_t)M * 16  , (signed char*)(F.ws + WS_A8), (float*)(F.ws + WS_QSINV), SSQ  };
          pg8::gemm_phase<pg8::EpiRes<true>, pg8::StaticOrder, pg8::AMapLinear, true, true>(F.lds, g, S, E, pg8::AMapLinear{}); }
        GRID_BAR();
        { pg8::Gemm g{(const bf16*)(F.ws + WS_A8), (const bf16*)(wl + WO_W8F), M, 2 * FF, 512, 512, 512}; pg8::StaticOrder S; S.init(M, 2 * FF, F.G, OPQ_BX());
          pg8::EpiSwiglu E{PROJ, SSQ + (size_t)M * 16, (const float*)(F.ws + WS_QSINV), (const float*)(wl + WO_CSF)};
          pg8::gemm_phase<pg8::EpiSwiglu, pg8::StaticOrder, pg8::AMapLinear, true, true, true>(F.lds, g, S, E, pg8::AMapLinear{}); }
        GRID_BAR();
        if (l + 1 < DEPTH) {
          { pg8::Gemm g{PROJ, (const bf16*)(wl + WO_WF2), M, D, FF, FF, FF}; pg8::StaticOrder S; S.init(M, D, F.G, OPQ_BX());
            pg8::EpiRes<true> E{(const float*)nullptr, XR, XR, SSQ  , (signed char*)(F.ws + WS_A8), (float*)(F.ws + WS_QSINV), SSQ + (size_t)M * 16  };
            pg8::gemm_phase<pg8::EpiRes<true>, pg8::StaticOrder, pg8::AMapLinear, true, true>(F.lds, g, S, E, pg8::AMapLinear{}); }
          GRID_BAR();
        } else if (F.G == 256) {
          { pg8::Gemm g{PROJ, (const bf16*)(wl + WO_WF2), M, D, FF, FF, FF}; pg8::StaticOrder S; S.init(M, D, F.G, OPQ_BX());
            pg8::EpiFinal E{XR2, F.out, SSQ, (unsigned*)(F.ws + WS_CTL) + CW_FIN, (const float*)inp(F, I_FNG)};
            pg8::gemm_phase<pg8::EpiFinal, pg8::StaticOrder, pg8::AMapLinear, true, true>(F.lds, g, S, E, pg8::AMapLinear{}); }
        } else {
          { pg8::Gemm g{PROJ, (const bf16*)(wl + WO_WF2), M, D, FF, FF, FF}; pg8::StaticOrder S; S.init(M, D, F.G, OPQ_BX());
            pg8::EpiRes<true> E{(const float*)nullptr, XR2, XN, SSQ, (signed char*)nullptr, (float*)(F.ws + WS_QSINV), SSQ + (size_t)M * 16};
            pg8::gemm_phase<pg8::EpiRes<true>, pg8::StaticOrder, pg8::AMapLinear, true, true>(F.lds, g, S, E, pg8::AMapLinear{}); }
          GRID_BAR();
          phase_final_norm(F, F.out, inp(F, I_FNG));
        }
    }
}

extern "C" void kernel_launch(void* const* d_in, const int* in_sizes, int n_in, void* d_out, int out_size, void* d_ws, size_t ws_size, hipStream_t stream) {
    static int grid = 0;
    if (grid == 0) {
        if (n_in != 20 || in_sizes[0] != M * D || out_size != M * D || ws_size < WS_END) { fprintf(stderr, "kernel_launch: unexpected shapes (n_in %d, in0 %d, out %d, ws %zu)\n", n_in, n_in > 0 ? in_sizes[0] : -1, out_size, ws_size); grid = -1; return; }
        int dev = 0, cus = 0, per_cu = 0;
        if (hipGetDevice(&dev) != hipSuccess || hipDeviceGetAttribute(&cus, hipDeviceAttributeMultiprocessorCount, dev) != hipSuccess) { grid = -1; return; }
        if (hipFuncSetAttribute((const void*)trunk_fwd, hipFuncAttributeMaxDynamicSharedMemorySize, LDS_BYTES) != hipSuccess) { fprintf(stderr, "kernel_launch: hipFuncSetAttribute failed\n"); grid = -1; return; }
        if (hipOccupancyMaxActiveBlocksPerMultiprocessor(&per_cu, (const void*)trunk_fwd, NWAVES * 64, LDS_BYTES) != hipSuccess || per_cu < 1)
            fprintf(stderr, "kernel_launch: note: occupancy query reports %d workgroups per CU\n", per_cu);
        (void)hipGetLastError();
        if (cus != 256) { fprintf(stderr, "kernel_launch: built for a 256-CU device (got %d)\n", cus); grid = -1; return; }
        grid = cus;
    }
    if (grid < 0) return;
    if (hipMemsetAsync((char*)d_ws + WS_CTL, 0, CTL_ZERO_BYTES, stream) != hipSuccess) return;
    Args a{};
    for (int i = 0; i < 20; ++i) a.in[i] = (const float*)d_in[i];
    a.out = (float*)d_out; a.ws = (unsigned char*)d_ws;
    hipLaunchKernelGGL(trunk_fwd, dim3(grid), dim3(NWAVES * 64), LDS_BYTES, stream, a);
}
```
